# Optimizing an MI355X kernel written in HIP

```python
import jax, jax.numpy as jnp
from jax import lax
import numpy as np

D_MODEL = 1024
BATCH = 4
SEQ = 4096
DEPTH = 2

MIX_WIDTH = D_MODEL
ATTN_WIDTH = MIX_WIDTH // 2
RET_WIDTH = MIX_WIDTH - ATTN_WIDTH
HEAD_DIM = 64
N_Q_HEADS = ATTN_WIDTH // HEAD_DIM
N_KV_HEADS = 2
GQA_GROUP = N_Q_HEADS // N_KV_HEADS
WINDOW = 128
BLOCK = 128
RET_HEADS = 4
RET_DK = RET_WIDTH // RET_HEADS
RET_DV = RET_WIDTH // RET_HEADS
CHUNK = 128
D_FF = 4 * D_MODEL
EPS = 1e-6
NEG_INF = -1e30
IN_SPLITS = (ATTN_WIDTH, N_KV_HEADS * HEAD_DIM, N_KV_HEADS * HEAD_DIM, RET_HEADS * RET_DK, RET_HEADS * RET_DK, RET_HEADS * RET_DV, RET_WIDTH)
IN_WIDTH = ATTN_WIDTH + 2 * N_KV_HEADS * HEAD_DIM + 2 * RET_HEADS * RET_DK + RET_HEADS * RET_DV + RET_WIDTH

kernel_name = 'hybrid_swa_sink_retention_adaln_block'


def rms_norm(x, gain):
    xf = x.astype(jnp.float32)
    y = xf * lax.rsqrt(jnp.mean(xf * xf, axis=-1, keepdims=True) + EPS)
    return (y * gain.astype(jnp.float32)).astype(x.dtype)


def alibi_slopes(n):
    return jnp.exp2(-8.0 * jnp.arange(1, n + 1, dtype=jnp.float32) / n)


def with_previous_block(t):
    prev = jnp.concatenate([jnp.zeros_like(t[:, :1]), t[:, :-1]], axis=1)
    return jnp.concatenate([prev, t], axis=2)


def sliding_window_sink_attention(q, k, v, q_gain, k_gain, sinks):
    b, s = q.shape[0], q.shape[1]
    nb = s // BLOCK
    q = rms_norm(q, q_gain).reshape(b, nb, BLOCK, N_KV_HEADS, GQA_GROUP, HEAD_DIM)
    k = with_previous_block(rms_norm(k, k_gain).reshape(b, nb, BLOCK, N_KV_HEADS, HEAD_DIM))
    v = with_previous_block(v.reshape(b, nb, BLOCK, N_KV_HEADS, HEAD_DIM))
    scores = jnp.einsum('bnqkgd,bnskd->bnkgqs', q, k, preferred_element_type=jnp.float32) * (HEAD_DIM ** -0.5)
    q_pos = jnp.arange(BLOCK)[:, None]
    k_pos = jnp.arange(2 * BLOCK)[None, :]
    dist = q_pos + BLOCK - k_pos
    valid = (dist >= 0) & (dist < WINDOW)
    valid = valid[None] & ((jnp.arange(nb)[:, None, None] > 0) | (k_pos[None] >= BLOCK))
    bias = -alibi_slopes(N_Q_HEADS)[:, None, None] * dist.astype(jnp.float32)
    scores = scores + bias.reshape(N_KV_HEADS, GQA_GROUP, BLOCK, 2 * BLOCK)
    scores = jnp.where(valid[None, :, None, None], scores, NEG_INF)
    sink = jnp.broadcast_to(sinks.astype(jnp.float32).reshape(N_KV_HEADS, GQA_GROUP, 1, 1), scores.shape[:-1] + (1,))
    probs = jax.nn.softmax(jnp.concatenate([scores, sink], axis=-1), axis=-1)[..., :-1]
    out = jnp.einsum('bnkgqs,bnskd->bnqkgd', probs.astype(v.dtype), v)
    return out.reshape(b, s, ATTN_WIDTH)


def multiscale_retention(q, k, v, g, norm_gain):
    b, s = q.shape[0], q.shape[1]
    nc = s // CHUNK
    f32 = jnp.float32
    qc = q.astype(f32).reshape(b, nc, CHUNK, RET_HEADS, RET_DK)
    kc = k.astype(f32).reshape(b, nc, CHUNK, RET_HEADS, RET_DK) * (RET_DK ** -0.5)
    vc = v.astype(f32).reshape(b, nc, CHUNK, RET_HEADS, RET_DV)
    log_gamma = jnp.log1p(-jnp.exp2(-5.0 - jnp.arange(RET_HEADS, dtype=f32)))
    idx = jnp.arange(CHUNK, dtype=f32)
    rel = idx[:, None] - idx[None, :]
    decay_in = jnp.where(rel >= 0, jnp.exp(log_gamma[:, None, None] * jnp.maximum(rel, 0.0)), 0.0)
    q_decay = jnp.exp(log_gamma[None, :] * (idx[:, None] + 1.0))
    k_decay = jnp.exp(log_gamma[None, :] * (CHUNK - 1.0 - idx[:, None]))
    chunk_decay = jnp.exp(log_gamma * CHUNK)
    inner = jnp.einsum('bnihd,bnjhd->bnhij', qc, kc) * decay_in
    o_inner = jnp.einsum('bnhij,bnjhe->bnihe', inner, vc)
    kv = jnp.einsum('bnjhd,bnjhe->bnhde', kc * k_decay[:, :, None], vc)

    def step(state, kv_n):
        return chunk_decay[None, :, None, None] * state + kv_n, state

    _, prev = lax.scan(step, jnp.zeros((b, RET_HEADS, RET_DK, RET_DV), f32), jnp.moveaxis(kv, 1, 0))
    prev = jnp.moveaxis(prev, 0, 1)
    o_cross = jnp.einsum('bnihd,bnhde->bnihe', qc, prev) * q_decay[:, :, None]
    o = (o_inner + o_cross).reshape(b, s, RET_HEADS, RET_DV)
    mu = jnp.mean(o, axis=-1, keepdims=True)
    var = jnp.mean(jnp.square(o - mu), axis=-1, keepdims=True)
    o = ((o - mu) * lax.rsqrt(var + EPS)).reshape(b, s, RET_WIDTH) * norm_gain.astype(f32)
    return (jax.nn.silu(g.astype(f32)) * o).astype(q.dtype)


def hybrid_layer(x, c_act, norm1_g, norm2_g, w_ada, b_ada, w_in, q_norm_g, k_norm_g, sinks, ret_norm_g, w_out, w_mlp1, w_mlp2):
    b, s = x.shape[0], x.shape[1]
    ada = (c_act @ w_ada + b_ada)[:, None, :]
    shift1, scale1, gate1, shift2, scale2, gate2 = jnp.split(ada, 6, axis=-1)
    h = rms_norm(x, norm1_g) * (1.0 + scale1) + shift1
    proj = h @ w_in
    offsets = np.cumsum(IN_SPLITS)[:-1].tolist()
    aq, ak, av, rq, rk, rv, rg = jnp.split(proj, offsets, axis=-1)
    attn = sliding_window_sink_attention(
        aq.reshape(b, s, N_Q_HEADS, HEAD_DIM),
        ak.reshape(b, s, N_KV_HEADS, HEAD_DIM),
        av.reshape(b, s, N_KV_HEADS, HEAD_DIM),
        q_norm_g, k_norm_g, sinks)
    ret = multiscale_retention(
        rq.reshape(b, s, RET_HEADS, RET_DK),
        rk.reshape(b, s, RET_HEADS, RET_DK),
        rv.reshape(b, s, RET_HEADS, RET_DV),
        rg, ret_norm_g)
    mixed = jnp.concatenate([attn.astype(x.dtype), ret.astype(x.dtype)], axis=-1) @ w_out
    x = x + gate1 * mixed
    h = rms_norm(x, norm2_g) * (1.0 + scale2) + shift2
    x = x + gate2 * (jnp.square(jax.nn.relu(h @ w_mlp1)) @ w_mlp2)
    return x


def setup_inputs(seed: int = 0) -> dict:
    key = jax.random.key(seed)
    ks = jax.random.split(key, 14)
    f32 = jnp.float32

    def normal(k, shape, scale):
        return jax.random.normal(k, shape, f32) * scale

    return {
        'x': normal(ks[0], (BATCH, SEQ, D_MODEL), 1.0),
        'c': normal(ks[1], (BATCH, D_MODEL), 1.0),
        'norm1_g': 1.0 + normal(ks[2], (DEPTH, D_MODEL), 0.05),
        'norm2_g': 1.0 + normal(ks[3], (DEPTH, D_MODEL), 0.05),
        'w_ada': normal(ks[4], (DEPTH, D_MODEL, 6 * D_MODEL), 0.5 * D_MODEL ** -0.5),
        'b_ada': normal(ks[5], (DEPTH, 6 * D_MODEL), 0.02),
        'w_in': normal(ks[6], (DEPTH, D_MODEL, IN_WIDTH), D_MODEL ** -0.5),
        'q_norm_g': 1.0 + normal(ks[7], (DEPTH, HEAD_DIM), 0.05),
        'k_norm_g': 1.0 + normal(ks[8], (DEPTH, HEAD_DIM), 0.05),
        'sinks': normal(ks[9], (DEPTH, N_Q_HEADS), 0.5),
        'ret_norm_g': 1.0 + normal(ks[10], (DEPTH, RET_WIDTH), 0.05),
        'w_out': normal(ks[11], (DEPTH, MIX_WIDTH, D_MODEL), MIX_WIDTH ** -0.5),
        'w_mlp1': normal(ks[12], (DEPTH, D_MODEL, D_FF), D_MODEL ** -0.5),
        'w_mlp2': normal(ks[13], (DEPTH, D_FF, D_MODEL), D_FF ** -0.5),
    }


def reference(x, c, norm1_g, norm2_g, w_ada, b_ada, w_in, q_norm_g, k_norm_g, sinks, ret_norm_g, w_out, w_mlp1, w_mlp2):
    c_act = jax.nn.silu(c)
    for layer in range(DEPTH):
        x = hybrid_layer(x, c_act, norm1_g[layer], norm2_g[layer], w_ada[layer], b_ada[layer], w_in[layer],
                         q_norm_g[layer], k_norm_g[layer], sinks[layer], ret_norm_g[layer], w_out[layer],
                         w_mlp1[layer], w_mlp2[layer])
    return x
```

```cpp
#include <hip/hip_runtime.h>
#include <cstdio>
#include <cstdint>
namespace pg8 {
#define PG8_LAS __attribute__((address_space(3)))
typedef unsigned short bf16_t;
typedef short bf16x8 __attribute__((ext_vector_type(8)));
typedef float f32x4 __attribute__((ext_vector_type(4)));
typedef unsigned u32x4 __attribute__((ext_vector_type(4)));
constexpr int BM = 256, BK = 64, HALF = 128, HTB = HALF * BK * 2  , STAGE_BYTES = 8 * HTB, NXCD = 8, WGM = 8;

__host__ __device__ __forceinline__ int lds_byte(int r, int c) { const int st = (r >> 4) * 2 + (c >> 5), rr = r & 15, cc = c & 31, ob = rr * 64 + cc * 2; return st * 1024 + (ob ^ (((ob >> 9) & 1) << 5)); }
__host__ __device__ __forceinline__ void stage_rc(int b, int& R, int& C) { const int st = b / 1024, sb = b % 1024, swz = sb ^ (((sb >> 9) & 1) << 5); R = (st >> 1) * 16 + swz / 64; C = (st & 1) * 32 + (swz % 64) / 2; }
__host__ __device__ __forceinline__ int perm32(int rho) { const int n = rho >> 4, i = rho & 15; return 8 * (i >> 2) + 4 * n + (i & 3); }

struct Unit { int pm, pn; };
struct Gemm { const bf16_t* A; const bf16_t* Bt; int M, N, K; };

struct StaticOrder {
    int nM, nN, nwg, G, c;
    __host__ __device__ void init(int M, int N, int G_, int c_) { nM = M / BM; nN = N / BM; nwg = nM * nN; G = G_; c = c_; }
    __host__ __device__ bool next(int i, Unit& u) const {
        const long L = (long)i * G + c; if (L >= nwg) return false;
        int wgid = (int)L; { const int q = nwg / NXCD, r = nwg % NXCD, xcd = wgid % NXCD, off = wgid / NXCD; wgid = (xcd < r ? xcd * (q + 1) : r * (q + 1) + (xcd - r) * q) + off; }
        const int nig = WGM * nN, gid = wgid / nig, fm = gid * WGM, gsz = (nM - fm) < WGM ? (nM - fm) : WGM;
        u.pm = fm + ((wgid % nig) % gsz); u.pn = (wgid % nig) / gsz; return true;
    }
    __device__ __forceinline__ void a_ready(const Unit&) const {}
    __device__ __forceinline__ void done(const Unit&) const {}
};


__device__ __forceinline__ unsigned cvt_pk_bf16(float lo, float hi) { unsigned r; asm volatile("v_cvt_pk_bf16_f32 %0, %1, %2" : "=v"(r) : "v"(lo), "v"(hi)); return r; }

template <int ACT  > struct EpiBf16 {
    static constexpr bool PERM = true, AFTER_DRAIN = false;
    bf16_t* O; int ldc;
    __device__ __forceinline__ void operator()(const f32x4 (&acc)[2][2][4][2], const Unit& u, int wr, int wc, int fr, int fq) const {
        const int row0 = u.pm * BM + wr * 64 + fr; const int col0 = u.pn * BM + wc * 32 + 8 * fq;
#pragma unroll
        for (int ai = 0; ai < 2; ++ai)
#pragma unroll
            for (int m = 0; m < 4; ++m) { bf16_t* rowp = O + (size_t)(row0 + ai * HALF + m * 16) * ldc + col0;
#pragma unroll
                for (int bj = 0; bj < 2; ++bj) { f32x4 v0 = acc[ai][bj][m][0], v1 = acc[ai][bj][m][1];
                    if (ACT == 1) {
#pragma unroll
                        for (int e = 0; e < 4; ++e) { const float a = fmaxf(v0[e], 0.f), b = fmaxf(v1[e], 0.f); v0[e] = a * a; v1[e] = b * b; } }
                    u32x4 w; w.x = cvt_pk_bf16(v0[0], v0[1]); w.y = cvt_pk_bf16(v0[2], v0[3]); w.z = cvt_pk_bf16(v1[0], v1[1]); w.w = cvt_pk_bf16(v1[2], v1[3]);
                    *(u32x4*)(rowp + bj * HALF) = w; } }
    }
};
struct EpiResGate {
    static constexpr bool PERM = false, AFTER_DRAIN = false;
    const float* base; float* out; int ldc; const float* gate; int gate_bstride; int rows_per_batch;
    __device__ __forceinline__ void operator()(const f32x4 (&acc)[2][2][4][2], const Unit& u, int wr, int wc, int fr, int fq) const {
        const int row0 = u.pm * BM + wr * 64 + fr, col0 = u.pn * BM + wc * 32 + 4 * fq;
        const float* gp = gate + (size_t)((u.pm * BM) / rows_per_batch) * gate_bstride + col0;
        f32x4 gv[2][2];
#pragma unroll
        for (int bj = 0; bj < 2; ++bj)
#pragma unroll
            for (int n = 0; n < 2; ++n) gv[bj][n] = *(const f32x4*)(gp + bj * HALF + n * 16);
#pragma unroll
        for (int ai = 0; ai < 2; ++ai)
#pragma unroll
            for (int m = 0; m < 4; ++m) { const size_t off = (size_t)(row0 + ai * HALF + m * 16) * ldc + col0;
#pragma unroll
                for (int bj = 0; bj < 2; ++bj)
#pragma unroll
                    for (int n = 0; n < 2; ++n) { const f32x4 bs = *(const f32x4*)(base + off + bj * HALF + n * 16);
                        *(f32x4*)(out + off + bj * HALF + n * 16) = bs + gv[bj][n] * acc[ai][bj][m][n]; } }
    }
};

template <class Epi, class Sched, bool ALIGN_EPI = false, bool SP2 = false>
__device__ __forceinline__ void gemm_phase(PG8_LAS unsigned char* lds, const Gemm g, const Sched& S, const Epi& E) {
    int tid_l = threadIdx.x; asm volatile("" : "+v"(tid_l));
    const int tid = tid_l, wid = __builtin_amdgcn_readfirstlane(tid >> 6), lane = tid & 63, wr = wid >> 2, wc = wid & 3, fr = lane & 15, fq = lane >> 4;
    const int K = g.K, nt = K / BK;
    unsigned voffA[2], voffB[2];
#pragma unroll
    for (int i = 0; i < 2; ++i) { int R, C; stage_rc(tid * 16 + i * 8192, R, C); const int Rb = Epi::PERM ? ((R & ~31) + perm32(R & 31)) : R;
        voffA[i] = (unsigned)(R * K + C) * 2u; voffB[i] = (unsigned)(Rb * K + C) * 2u; }
    const size_t kstep = (size_t)(BK * 2);
    const size_t hstep = (size_t)HALF * K * 2;
    const size_t tstep = 2 * hstep;
    const unsigned ldsw = (unsigned)wid * 1024u;
    const int aoff = lds_byte(wr * 64 + fr, fq * 8), boff = lds_byte(wc * 32 + fr, fq * 8);
#define PG8_SA(b, h) (((b) * 2 + (h)) * HTB)
#define PG8_SB(b, h) ((4 + (b) * 2 + (h)) * HTB)
#define PG8_STAGE(bufoff, gbase, voff) do { _Pragma("unroll") for (int _i = 0; _i < 2; ++_i) \
        __builtin_amdgcn_global_load_lds((const unsigned*)((const char*)(gbase) + (voff)[_i]), (PG8_LAS unsigned*)(lds + (bufoff) + ldsw + _i * 8192), 16, 0, 0); } while (0)
#define PG8_LDA(dst, b, h) do { _Pragma("unroll") for (int m = 0; m < 4; ++m) _Pragma("unroll") for (int k = 0; k < 2; ++k) dst[m][k] = *(const PG8_LAS bf16x8*)(lds + PG8_SA(b, h) + aoff + m * 2048 + k * 1024); } while (0)
#define PG8_LDB(dst, b, h) do { _Pragma("unroll") for (int n = 0; n < 2; ++n) _Pragma("unroll") for (int k = 0; k < 2; ++k) dst[n][k] = *(const PG8_LAS bf16x8*)(lds + PG8_SB(b, h) + boff + n * 2048 + k * 1024); } while (0)
#define PG8_MMA(ai, bj, At, Bt) do { __builtin_amdgcn_s_setprio(1); _Pragma("unroll") for (int m = 0; m < 4; ++m) _Pragma("unroll") for (int n = 0; n < 2; ++n) _Pragma("unroll") for (int k = 0; k < 2; ++k) \
        acc[ai][bj][m][n] = __builtin_amdgcn_mfma_f32_16x16x32_bf16(Bt[n][k], At[m][k], acc[ai][bj][m][n], 0, 0, 0); __builtin_amdgcn_s_setprio(0); } while (0)
#define PG8_WAIT_V(n) asm volatile("s_waitcnt vmcnt(" #n ")" ::: "memory")
#define PG8_WAIT_L(n) asm volatile("s_waitcnt lgkmcnt(" #n ")" ::: "memory")
#define PG8_BAR __builtin_amdgcn_s_barrier()
#define PG8_SCHED __builtin_amdgcn_sched_barrier(0)
    Unit cur, nxt; int ui = 0;
    if (!S.next(0, cur)) return;
    f32x4 acc[2][2][4][2];
#pragma unroll
    for (int a = 0; a < 2; ++a)
#pragma unroll
        for (int b = 0; b < 2; ++b)
#pragma unroll
            for (int m = 0; m < 4; ++m)
#pragma unroll
                for (int n = 0; n < 2; ++n) acc[a][b][m][n] = (f32x4){0.f, 0.f, 0.f, 0.f};
    bf16x8 At[4][2], B0[2][2], B1[2][2];
    const char* cA = (const char*)g.A + (size_t)cur.pm * tstep; const char* cB = (const char*)g.Bt + (size_t)cur.pn * tstep;
    S.a_ready(cur);
    if constexpr (SP2) {
        PG8_STAGE(PG8_SB(0, 0), cB, voffB); PG8_STAGE(PG8_SB(0, 1), cB + hstep, voffB); PG8_STAGE(PG8_SA(0, 0), cA, voffA); PG8_STAGE(PG8_SA(0, 1), cA + hstep, voffA);
        if (wr == 1) PG8_BAR;
        PG8_WAIT_V(2); PG8_BAR;
        PG8_STAGE(PG8_SB(1, 0), cB + kstep, voffB); PG8_STAGE(PG8_SA(1, 0), cA + kstep, voffA); PG8_STAGE(PG8_SB(1, 1), cB + hstep + kstep, voffB);
        PG8_WAIT_V(6); PG8_BAR;
    } else {
        PG8_STAGE(PG8_SB(0, 0), cB, voffB); PG8_STAGE(PG8_SA(0, 0), cA, voffA); PG8_STAGE(PG8_SB(0, 1), cB + hstep, voffB); PG8_STAGE(PG8_SA(0, 1), cA + hstep, voffA);
        if (wr == 1) PG8_BAR;
        PG8_WAIT_V(4); PG8_BAR;
        PG8_STAGE(PG8_SB(1, 0), cB + kstep, voffB); PG8_STAGE(PG8_SA(1, 0), cA + kstep, voffA); PG8_STAGE(PG8_SB(1, 1), cB + hstep + kstep, voffB);
        PG8_WAIT_V(6); PG8_BAR;
    }
    for (;;) {
        const bool has_next = S.next(ui + 1, nxt);
        const char* nA = has_next ? (const char*)g.A + (size_t)nxt.pm * tstep : cA; const char* nB = has_next ? (const char*)g.Bt + (size_t)nxt.pn * tstep : cB;
        for (int t = 0; t < nt; t += 2) {
            const bool last = (t == nt - 2);
            const char* a1 = cA + (size_t)(t + 1) * kstep;
            const char* a2 = last ? nA : cA + (size_t)(t + 2) * kstep; const char* b2 = last ? nB : cB + (size_t)(t + 2) * kstep;
            const char* a3 = a2 + kstep; const char* b3 = b2 + kstep;
            if (last && has_next) S.a_ready(nxt);
            if constexpr (SP2) {
            PG8_LDB(B0, 0, 0); PG8_LDB(B1, 0, 1); PG8_SCHED; PG8_LDA(At, 0, 0); PG8_STAGE(PG8_SA(1, 1), a1 + hstep, voffA);
            PG8_WAIT_V(8); PG8_WAIT_L(0); PG8_BAR; PG8_MMA(0, 0, At, B0); PG8_MMA(0, 1, At, B1); PG8_BAR; PG8_SCHED;
            PG8_LDA(At, 0, 1); PG8_STAGE(PG8_SB(0, 0), b2, voffB); PG8_STAGE(PG8_SB(0, 1), b2 + hstep, voffB); PG8_STAGE(PG8_SA(0, 0), a2, voffA);
            PG8_WAIT_V(8); PG8_WAIT_L(0); PG8_BAR; PG8_MMA(1, 0, At, B0); PG8_MMA(1, 1, At, B1); PG8_BAR; PG8_SCHED;
            PG8_LDB(B0, 1, 0); PG8_LDB(B1, 1, 1); PG8_SCHED; PG8_LDA(At, 1, 0); PG8_STAGE(PG8_SA(0, 1), a2 + hstep, voffA);
            PG8_WAIT_V(8); PG8_WAIT_L(0); PG8_BAR; PG8_MMA(0, 0, At, B0); PG8_MMA(0, 1, At, B1); PG8_BAR; PG8_SCHED;
            PG8_LDA(At, 1, 1); PG8_STAGE(PG8_SB(1, 0), b3, voffB); PG8_STAGE(PG8_SB(1, 1), b3 + hstep, voffB); PG8_STAGE(PG8_SA(1, 0), a3, voffA);
            PG8_WAIT_V(8); PG8_WAIT_L(0); PG8_BAR; PG8_MMA(1, 0, At, B0); PG8_MMA(1, 1, At, B1); PG8_BAR; PG8_SCHED;
            } else {
            PG8_LDB(B0, 0, 0); PG8_SCHED; PG8_LDA(At, 0, 0); PG8_STAGE(PG8_SA(1, 1), a1 + hstep, voffA);
            PG8_WAIT_L(8); PG8_BAR; PG8_WAIT_L(0); PG8_MMA(0, 0, At, B0); PG8_BAR; PG8_SCHED;
            PG8_LDB(B1, 0, 1); PG8_STAGE(PG8_SB(0, 0), b2, voffB);
            PG8_BAR; PG8_WAIT_L(0); PG8_MMA(0, 1, At, B1); PG8_BAR;
            PG8_LDA(At, 0, 1); PG8_STAGE(PG8_SA(0, 0), a2, voffA);
            PG8_BAR; PG8_WAIT_L(0); PG8_MMA(1, 0, At, B0); PG8_BAR; PG8_SCHED;
            PG8_STAGE(PG8_SB(0, 1), b2 + hstep, voffB);
            PG8_WAIT_V(6); PG8_BAR; PG8_MMA(1, 1, At, B1); PG8_BAR;
            PG8_LDB(B0, 1, 0); PG8_SCHED; PG8_LDA(At, 1, 0); PG8_STAGE(PG8_SA(0, 1), a2 + hstep, voffA);
            PG8_WAIT_L(8); PG8_BAR; PG8_WAIT_L(0); PG8_MMA(0, 0, At, B0); PG8_BAR; PG8_SCHED;
            PG8_LDB(B1, 1, 1); PG8_STAGE(PG8_SB(1, 0), b3, voffB);
            PG8_BAR; PG8_WAIT_L(0); PG8_MMA(0, 1, At, B1); PG8_BAR;
            PG8_LDA(At, 1, 1); PG8_STAGE(PG8_SA(1, 0), a3, voffA);
            PG8_BAR; PG8_WAIT_L(0); PG8_MMA(1, 0, At, B0); PG8_BAR; PG8_SCHED;
            PG8_STAGE(PG8_SB(1, 1), b3 + hstep, voffB);
            PG8_WAIT_V(6); PG8_BAR; PG8_MMA(1, 1, At, B1); PG8_BAR;
            }
        }
        if constexpr (ALIGN_EPI) { if (wr == 0) PG8_BAR; }
        if constexpr (!Epi::AFTER_DRAIN) { E(acc, cur, wr, wc, fr, fq); S.done(cur); }
        if (!has_next) break;
#pragma unroll
        for (int a = 0; a < 2; ++a)
#pragma unroll
            for (int b = 0; b < 2; ++b)
#pragma unroll
                for (int m = 0; m < 4; ++m)
#pragma unroll
                    for (int n = 0; n < 2; ++n) acc[a][b][m][n] = (f32x4){0.f, 0.f, 0.f, 0.f};
        cur = nxt; cA = nA; cB = nB; ++ui;
        if constexpr (ALIGN_EPI) { if (wr == 1) PG8_BAR; }
    }
    PG8_WAIT_V(0);
    if constexpr (!ALIGN_EPI) { if (wr == 0) PG8_BAR; }
    PG8_BAR;
    if constexpr (Epi::AFTER_DRAIN) { E.fused(acc, cur, wr, wc, fr, fq, lds, wid, lane); S.done(cur); }
#undef PG8_SA
#undef PG8_SB
#undef PG8_STAGE
#undef PG8_LDA
#undef PG8_LDB
#undef PG8_MMA
#undef PG8_WAIT_V
#undef PG8_WAIT_L
#undef PG8_BAR
#undef PG8_SCHED
}
}

#ifndef PG8_SP2
#define PG8_SP2 true
#endif
#ifndef PG8_ALIGN
#define PG8_ALIGN true
#endif
constexpr int NWAVES = 8;
#ifndef MK_N_LAUNCHES
#define MK_N_LAUNCHES 19
#endif
constexpr int BATCH = 4, SEQ = 4096, D = 1024, M = BATCH * SEQ, NIN = 2816, FF = 4096, NLAYER = 2, ADA = 6 * D;
constexpr int C_AQ = 0, C_AK = 512, C_AV = 640, C_RQ = 768, C_RK = 1280, C_RV = 1792, C_RG = 2304;
constexpr float EPS = 1e-6f;
constexpr int PH_PER_LAYER = 9, NPHASE = 1 + PH_PER_LAYER * NLAYER;
constexpr int N_LAUNCHES = MK_N_LAUNCHES;

constexpr size_t MiB = 1u << 20;
constexpr size_t WS_CTL = 0, CTL_ZERO_BYTES = 1 * MiB;
constexpr size_t WS_ADA = 512 * 1024;
constexpr size_t WS_W = 1 * MiB, W_LAYER = 47 * MiB / 2;
constexpr size_t WO_IN = 0, WO_OUT = 11 * MiB / 2, WO_1 = 15 * MiB / 2, WO_2 = 31 * MiB / 2;
constexpr size_t WS_XN = 48 * MiB;
constexpr size_t WS_H = 80 * MiB;
constexpr size_t WS_PROJ = 80 * MiB;
constexpr size_t WS_MIX = 168 * MiB;
constexpr size_t WS_KV = 208 * MiB;
constexpr size_t WS_PREV = 240 * MiB;
constexpr size_t WS_END = 256 * MiB;
static_assert(WS_W + NLAYER * W_LAYER <= WS_XN && WS_XN + (size_t)M * D * 2 <= WS_H && WS_PROJ + (size_t)M * NIN * 2 <= WS_MIX && WS_MIX + (size_t)M * D * 2 <= WS_KV && WS_H + (size_t)M * FF * 2 <= WS_KV && WS_PREV + 512u * 16384 * 2 <= WS_END, "d_ws map");
constexpr int CW_TMO = 0, CW_CODE = 1;
constexpr int CW_BAR = 4096;

constexpr int RING_OFF = 0, RING_BYTES = 131072;
constexpr int LDSCTL_OFF = RING_BYTES, MISC_OFF = LDSCTL_OFF + 320;
constexpr int LDS_BYTES = 147456;
static_assert(MISC_OFF + 128 <= LDS_BYTES, "LDS map");

#define GAS __attribute__((address_space(1)))
#define LAS __attribute__((address_space(3)))
typedef unsigned short bf16;
typedef unsigned v4u __attribute__((ext_vector_type(4)));
typedef float f32x4 __attribute__((ext_vector_type(4)));
typedef short bf16x8 __attribute__((ext_vector_type(8)));
typedef GAS unsigned gu32;
typedef GAS unsigned long long gu64;
#define RLX_AGENT __ATOMIC_RELAXED, __HIP_MEMORY_SCOPE_AGENT
#define LDS_WAIT() asm volatile("s_waitcnt lgkmcnt(0)" ::: "memory")
#define VM_WAIT() asm volatile("s_waitcnt vmcnt(0)" ::: "memory")
__device__ __forceinline__ unsigned long long rt() { return __builtin_amdgcn_s_memrealtime(); }
__device__ __forceinline__ unsigned f2bf(float f) { unsigned u = __builtin_bit_cast(unsigned, f); return (u + 0x7fffu + ((u >> 16) & 1u)) >> 16; }
__device__ __forceinline__ unsigned pk2(float lo, float hi) { return f2bf(lo) | (f2bf(hi) << 16); }

#define XB_TMO      128
#define XB_XCNT(j)  (256  + 64 * (j))
#define XB_XSUB(j)  (1280 + 64 * (j))
#define XB_XGEN(j)  (2304 + 64 * (j))
#define XB_TOP      3328
#define XB_TOPGEN   3392
#define XCD_BAR_WORDS 3456
#define XB_SPIN_CAP (1u << 18)

__device__ __forceinline__ unsigned xb_ld(unsigned* p)              { return __hip_atomic_load(p, __ATOMIC_RELAXED, __HIP_MEMORY_SCOPE_AGENT); }
__device__ __forceinline__ unsigned xb_add(unsigned* p, unsigned v) { return __hip_atomic_fetch_add(p, v, __ATOMIC_RELAXED, __HIP_MEMORY_SCOPE_AGENT); }
__device__ __forceinline__ unsigned xb_xcc_id() { return (unsigned)__builtin_amdgcn_s_getreg((3 << 11) | 20) & 0xFu; }
#define XB_SPIN(cond, bar) do { unsigned _sp = 0; while (cond) { __builtin_amdgcn_s_sleep(1); \
    if ((++_sp & 255u) == 0u) { if (xb_ld(&(bar)[XB_TMO])) break; if (_sp > XB_SPIN_CAP) { atomicAdd(&(bar)[XB_TMO], 1u); break; } } } } while (0)

struct XcdBarrier {
    unsigned* bar; unsigned x;
    volatile LAS unsigned* st;
};

__device__ __forceinline__ XcdBarrier xcd_barrier_post(unsigned* bar, volatile LAS unsigned* st) {
    XcdBarrier b; b.bar = bar; b.x = xb_xcc_id(); b.st = st;
    if (threadIdx.x == 0) (void)xb_add(&bar[XB_XCNT(b.x)], 1u);
    return b;
}
__device__ __forceinline__ void xcd_barrier_complete(unsigned* bar, unsigned x, unsigned& nloc, unsigned& nx) {
    const unsigned G = gridDim.x * gridDim.y * gridDim.z;
    unsigned sum, cnt, mine, sp = 0u;
    for (;;) {
        sum = 0u; cnt = 0u; mine = 0u;
#pragma unroll
        for (unsigned j = 0; j < 16; ++j) { const unsigned c = xb_ld(&bar[XB_XCNT(j)]); sum += c; cnt += (c > 0u) ? 1u : 0u; mine = (j == x) ? c : mine; }
        if (sum == G) break;
        __builtin_amdgcn_s_sleep(1);
        if ((++sp & 255u) == 0u) { if (xb_ld(&bar[XB_TMO])) break; if (sp > XB_SPIN_CAP) { atomicAdd(&bar[XB_TMO], 1u); break; } }
    }
    nloc = mine > 0u ? mine : 1u; nx = cnt > 0u ? cnt : 1u;
}

__device__ __forceinline__ void xcd_barrier(const XcdBarrier& b) {
    asm volatile("s_waitcnt vmcnt(0)" ::: "memory");
    __syncthreads();
    if (threadIdx.x == 0) {
        unsigned* bar = b.bar;
        __builtin_amdgcn_s_waitcnt(0);
        unsigned nloc = b.st[0], nx = b.st[1];
        if (nloc == 0u) { xcd_barrier_complete(bar, b.x, nloc, nx); b.st[0] = nloc; b.st[1] = nx; }
        const unsigned old = xb_add(&bar[XB_XSUB(b.x)], 1u);
        const unsigned gen = old / nloc;
        if (old + 1u == (gen + 1u) * nloc) {
            __builtin_amdgcn_fence(__ATOMIC_RELEASE, "agent");
            asm volatile("s_waitcnt vmcnt(0)" ::: "memory");
            const unsigned og = xb_add(&bar[XB_TOP], 1u);
            const unsigned tg = og / nx;
            if (og + 1u == (tg + 1u) * nx) xb_add(&bar[XB_TOPGEN], 1u);
            else XB_SPIN(xb_ld(&bar[XB_TOPGEN]) == tg, bar);
            __builtin_amdgcn_fence(__ATOMIC_ACQUIRE, "agent");
            xb_add(&bar[XB_XGEN(b.x)], 1u);
            asm volatile("s_waitcnt vmcnt(0)" ::: "memory");
        } else {
            XB_SPIN(xb_ld(&bar[XB_XGEN(b.x)]) == gen, bar);
            __builtin_amdgcn_fence(__ATOMIC_ACQUIRE, "agent");
            asm volatile("s_waitcnt vmcnt(0)" ::: "memory");
        }
    }
    __syncthreads();
}

struct Frame {
    LAS unsigned char* lds;
    volatile LAS unsigned* MISC;
    gu32* ctl;
    int tid, lane, wave;
    int vcu, G;
    const float *x, *c, *n1g, *n2g, *w_ada, *b_ada, *w_in, *qng, *kng, *sinks, *rng, *w_out, *w_1, *w_2;
    float* out; float* ada;
    unsigned char* ws;
};
#define LAUNDER(F) do { int t_ = threadIdx.x; asm volatile("" : "+v"(t_)); (F).tid = t_; (F).lane = t_ & 63; } while (0)
__device__ __forceinline__ float bf2f(unsigned short u) { return __uint_as_float(((unsigned)u) << 16); }
__device__ __forceinline__ float bflo(unsigned u) { return __uint_as_float(u << 16); }
__device__ __forceinline__ float bfhi(unsigned u) { return __uint_as_float(u & 0xffff0000u); }
__device__ __forceinline__ void unpack8(const v4u w, float* f) { f[0] = bflo(w.x); f[1] = bfhi(w.x); f[2] = bflo(w.y); f[3] = bfhi(w.y); f[4] = bflo(w.z); f[5] = bfhi(w.z); f[6] = bflo(w.w); f[7] = bfhi(w.w); }
__device__ __forceinline__ float wave_sum(float v) {
#pragma unroll
    for (int o = 1; o < 64; o <<= 1) v += __shfl_xor(v, o);
    return v;
}
__device__ __forceinline__ float ret_log_gamma(int h) { return log1pf(-exp2f(-5.0f - (float)h)); }

__device__ __forceinline__ void p0_transpose_item(const float* W, int K, int N, bf16* WT, int row_off, LAS float* scr, int item, int lane) {
    const int nblk = N / 32, kb = item / nblk, nb = item % nblk, k0 = 64 * kb, n0 = 32 * nb;
#pragma unroll 8
    for (int i = 0; i < 32; ++i) { const int kk = 2 * i + (lane >> 5); scr[kk * 33 + (lane & 31)] = W[(size_t)(k0 + kk) * N + n0 + (lane & 31)]; }
    LDS_WAIT(); asm volatile("" ::: "memory");
    const int c = lane & 7;
#pragma unroll
    for (int j = 0; j < 4; ++j) { const int n = (lane >> 3) + 8 * j; const LAS float* s = scr + (8 * c) * 33 + n;
        v4u o; o.x = pk2(s[0 * 33], s[1 * 33]); o.y = pk2(s[2 * 33], s[3 * 33]); o.z = pk2(s[4 * 33], s[5 * 33]); o.w = pk2(s[6 * 33], s[7 * 33]);
        *(GAS v4u*)(WT + (size_t)(row_off + n0 + n) * K + k0 + 8 * c) = o; }
    LDS_WAIT(); asm volatile("" ::: "memory");
}
__device__ __forceinline__ void p0_ada_item(Frame& F, int item, LAS float* scr) {
    const int ks = item & 3, cb = (item >> 2) % (ADA / 64), l = (item >> 2) / (ADA / 64), k0 = ks * 256, j = cb * 64 + F.lane;
#pragma unroll
    for (int i = 0; i < 4; ++i) { const int kk = i * 64 + F.lane;
#pragma unroll
        for (int b = 0; b < BATCH; ++b) { const float cv = F.c[b * D + k0 + kk]; scr[kk * 4 + b] = cv / (1.0f + __expf(-cv)); } }
    LDS_WAIT(); asm volatile("" ::: "memory");
    const float* w = F.w_ada + ((size_t)l * D + k0) * ADA + j;
    float a0 = 0.f, a1 = 0.f, a2 = 0.f, a3 = 0.f;
#pragma unroll 8
    for (int k = 0; k < 256; ++k) { const float wv = w[(size_t)k * ADA]; const f32x4 cv = *(const LAS f32x4*)(scr + k * 4); a0 += cv.x * wv; a1 += cv.y * wv; a2 += cv.z * wv; a3 += cv.w * wv; }
    if (ks == 0) { const float bv = F.b_ada[l * ADA + j]; a0 += bv; a1 += bv; a2 += bv; a3 += bv; }
    float* ad = F.ada + (size_t)(l * BATCH) * ADA + j;
    atomicAdd(ad, a0); atomicAdd(ad + ADA, a1); atomicAdd(ad + 2 * ADA, a2); atomicAdd(ad + 3 * ADA, a3);
    LDS_WAIT(); asm volatile("" ::: "memory");
}
__device__ __forceinline__ void p0_prologue(Frame& F) {
    LAUNDER(F);
    LAS float* scr = (LAS float*)(F.lds + RING_OFF + F.wave * 16384);
    const int gw = F.vcu * NWAVES + F.wave, NGW = F.G * NWAVES;
    constexpr int I_IN = (D / 64) * (NIN / 32), I_O = (D / 64) * (D / 32), I_1 = (D / 64) * (FF / 32), I_2 = (FF / 64) * (D / 32), I_L = I_IN + I_O + I_1 + I_2;
    constexpr int I_ADA = NLAYER * (ADA / 64) * 4;
    constexpr int NITEMS = I_ADA + NLAYER * I_L;
    for (int it = gw; it < NITEMS; it += NGW) {
        int r = it;
        if (r < I_ADA) { p0_ada_item(F, r, scr); continue; } r -= I_ADA;
        const int l = r / I_L; r -= l * I_L;
        bf16* wl = (bf16*)(F.ws + WS_W + (size_t)l * W_LAYER);
        if (r < I_IN) { p0_transpose_item(F.w_in + (size_t)l * D * NIN, D, NIN, wl + WO_IN / 2, 0, scr, r, F.lane); continue; } r -= I_IN;
        if (r < I_O) { p0_transpose_item(F.w_out + (size_t)l * D * D, D, D, wl + WO_OUT / 2, 0, scr, r, F.lane); continue; } r -= I_O;
        if (r < I_1) { p0_transpose_item(F.w_1 + (size_t)l * D * FF, D, FF, wl + WO_1 / 2, 0, scr, r, F.lane); continue; } r -= I_1;
        p0_transpose_item(F.w_2 + (size_t)l * FF * D, FF, D, wl + WO_2 / 2, 0, scr, r, F.lane);
    }
}
__device__ __forceinline__ void xn_phase(Frame& F, const float* xsrc, const float* g, const float* shift, const float* scale, bf16* XN) {
    LAUNDER(F);
    const int gw = F.vcu * NWAVES + F.wave, NGW = F.G * NWAVES;
    for (int rb = gw; rb < M / 8; rb += NGW) {
        const int b = (rb * 8) / SEQ;
        f32x4 gm[4], sh[4];
#pragma unroll
        for (int j = 0; j < 4; ++j) { const int col = 256 * j + 4 * F.lane; const f32x4 gg = *(const f32x4*)(g + col), sc = *(const f32x4*)(scale + (size_t)b * ADA + col); gm[j] = gg * (sc + 1.0f); sh[j] = *(const f32x4*)(shift + (size_t)b * ADA + col); }
#pragma unroll 2
        for (int r = 0; r < 8; ++r) { const size_t row = (size_t)rb * 8 + r;
            const GAS f32x4* xr = (const GAS f32x4*)(xsrc + row * D) + F.lane;
            f32x4 v[4]; float s = 0.f;
#pragma unroll
            for (int j = 0; j < 4; ++j) { v[j] = xr[64 * j]; s += (v[j].x * v[j].x + v[j].y * v[j].y) + (v[j].z * v[j].z + v[j].w * v[j].w); }
            const float rstd = 1.0f / sqrtf(wave_sum(s) * (1.0f / D) + EPS);
            GAS unsigned long long* o8 = (GAS unsigned long long*)(XN + row * D) + F.lane;
#pragma unroll
            for (int j = 0; j < 4; ++j) { const f32x4 o = v[j] * rstd * gm[j] + sh[j]; o8[64 * j] = (unsigned long long)pk2(o.x, o.y) | ((unsigned long long)pk2(o.z, o.w) << 32); }
        }
    }
}

__device__ __forceinline__ void attn_simple(Frame& F, int layer, const bf16* PROJ, bf16* MIX) {
    LAUNDER(F);
    LAS float* Kh = (LAS float*)(F.lds + RING_OFF);
    LAS unsigned short* Vh = (LAS unsigned short*)(F.lds + RING_OFF + 65536);
    const float* qg = F.qng + layer * 64; const float* kg = F.kng + layer * 64; const float* sk = F.sinks + layer * 8;
    const int tid = F.tid;
    for (int u = F.vcu; u < BATCH * 32 * 2; u += F.G) {
        const int kvh = u & 1, n = (u >> 1) & 31, b = u >> 6;
        __syncthreads();
        { const int r = tid >> 1, hf = tid & 1; const int tok = (n - 1) * 128 + r;
          float kf[32]; float ss = 0.f;
          if (tok >= 0) {
              const bf16* kp = PROJ + (size_t)(b * SEQ + tok) * NIN + C_AK + kvh * 64 + hf * 32;
              const bf16* vp = PROJ + (size_t)(b * SEQ + tok) * NIN + C_AV + kvh * 64 + hf * 32;
#pragma unroll
              for (int i = 0; i < 4; ++i) { const v4u w = *(const GAS v4u*)(kp + 8 * i); unpack8(w, kf + 8 * i); const v4u vw = *(const GAS v4u*)(vp + 8 * i); *(LAS v4u*)(Vh + r * 64 + hf * 32 + 8 * i) = vw; }
#pragma unroll
              for (int i = 0; i < 32; ++i) ss += kf[i] * kf[i];
          } else {
#pragma unroll
              for (int i = 0; i < 32; ++i) kf[i] = 0.f;
#pragma unroll
              for (int i = 0; i < 4; ++i) *(LAS v4u*)(Vh + r * 64 + hf * 32 + 8 * i) = (v4u){0u, 0u, 0u, 0u};
          }
          ss += __shfl_xor(ss, 1);
          const float rstd = 1.0f / sqrtf(ss * (1.0f / 64.0f) + EPS);
#pragma unroll
          for (int i = 0; i < 32; ++i) Kh[r * 64 + hf * 32 + i] = kf[i] * rstd * kg[hf * 32 + i];
        }
        __syncthreads();
        const int q = tid >> 2, p = tid & 3; const size_t row = (size_t)b * SEQ + n * 128 + q;
        const int q0w = (tid >> 6) * 16;
        for (int gq = 0; gq < 4; ++gq) {
            const int h = kvh * 4 + gq;
            const float slope = exp2f(-(float)(h + 1)); const float sink = sk[h];
            float qf[16]; float ss = 0.f;
            { const bf16* qp = PROJ + row * NIN + C_AQ + h * 64 + p * 16;
              const v4u w0 = *(const GAS v4u*)(qp), w1 = *(const GAS v4u*)(qp + 8); unpack8(w0, qf); unpack8(w1, qf + 8); }
#pragma unroll
            for (int i = 0; i < 16; ++i) ss += qf[i] * qf[i];
            ss += __shfl_xor(ss, 1); ss += __shfl_xor(ss, 2);
            const float rstd = 1.0f / sqrtf(ss * (1.0f / 64.0f) + EPS);
#pragma unroll
            for (int i = 0; i < 16; ++i) qf[i] = qf[i] * rstd * qg[p * 16 + i];
            float mx = sink, l = 1.0f, o[16];
#pragma unroll
            for (int i = 0; i < 16; ++i) o[i] = 0.f;
            const int k_lo = (n == 0) ? 128 : q0w + 1, k_hi = q0w + 15 + 128;
            for (int kp = k_lo; kp <= k_hi; ++kp) {
                const int dist = q + 128 - kp;
                float dot = 0.f;
#pragma unroll
                for (int i = 0; i < 16; ++i) dot += qf[i] * Kh[kp * 64 + p * 16 + i];
                dot += __shfl_xor(dot, 1); dot += __shfl_xor(dot, 2);
                if (dist >= 0 && dist < 128) {
                    const float s = dot * 0.125f - slope * (float)dist;
                    const float mn = fmaxf(mx, s), al = __expf(mx - mn), pp = __expf(s - mn);
                    l = l * al + pp;
#pragma unroll
                    for (int i = 0; i < 16; ++i) o[i] = o[i] * al + pp * bf2f(Vh[kp * 64 + p * 16 + i]);
                    mx = mn;
                }
            }
            const float inv = 1.0f / l;
            v4u w0, w1;
            w0.x = pk2(o[0] * inv, o[1] * inv); w0.y = pk2(o[2] * inv, o[3] * inv); w0.z = pk2(o[4] * inv, o[5] * inv); w0.w = pk2(o[6] * inv, o[7] * inv);
            w1.x = pk2(o[8] * inv, o[9] * inv); w1.y = pk2(o[10] * inv, o[11] * inv); w1.z = pk2(o[12] * inv, o[13] * inv); w1.w = pk2(o[14] * inv, o[15] * inv);
            bf16* op = MIX + row * D + h * 64 + p * 16;
            *(GAS v4u*)(op) = w0; *(GAS v4u*)(op + 8) = w1;
        }
    }
    __syncthreads();
}
__device__ __forceinline__ void ret_kv_simple(Frame& F, const bf16* PROJ, float* KV) {
    LAUNDER(F);
    LAS unsigned short* kd = (LAS unsigned short*)(F.lds + RING_OFF);
    LAS unsigned short* vv = (LAS unsigned short*)(F.lds + RING_OFF + 32768);
    const int tid = F.tid;
    for (int u = F.vcu; u < 512; u += F.G) {
        const int h = u & 3, bn = u >> 2; const size_t row0 = (size_t)bn * 128;
        const float lg = ret_log_gamma(h);
        __syncthreads();
        { const int r = tid >> 2, part = tid & 3;
          const bf16* kp = PROJ + (row0 + r) * NIN + C_RK + h * 128 + part * 32;
          const bf16* vp = PROJ + (row0 + r) * NIN + C_RV + h * 128 + part * 32;
          const float dk = __expf(lg * (float)(127 - r)) * 0.08838834764831845f;
#pragma unroll
          for (int i = 0; i < 4; ++i) { const v4u w = *(const GAS v4u*)(kp + 8 * i); float f[8]; unpack8(w, f);
              v4u o; o.x = pk2(f[0] * dk, f[1] * dk); o.y = pk2(f[2] * dk, f[3] * dk); o.z = pk2(f[4] * dk, f[5] * dk); o.w = pk2(f[6] * dk, f[7] * dk);
              *(LAS v4u*)(kd + r * 128 + part * 32 + 8 * i) = o;
              *(LAS v4u*)(vv + r * 128 + part * 32 + 8 * i) = *(const GAS v4u*)(vp + 8 * i); }
        }
        __syncthreads();
        const int d = tid >> 2, p = tid & 3;
        float acc[32];
#pragma unroll
        for (int e = 0; e < 32; ++e) acc[e] = 0.f;
        for (int j = 0; j < 128; ++j) {
            const float kk = bf2f(kd[j * 128 + d]);
#pragma unroll
            for (int i = 0; i < 4; ++i) { const v4u w = *(const LAS v4u*)(vv + j * 128 + p * 32 + 8 * i); float f[8]; unpack8(w, f);
#pragma unroll
                for (int e = 0; e < 8; ++e) acc[8 * i + e] += kk * f[e]; }
        }
        float* op = KV + ((size_t)u * 128 + d) * 128 + p * 32;
#pragma unroll
        for (int i = 0; i < 8; ++i) *(GAS f32x4*)(op + 4 * i) = (f32x4){acc[4 * i], acc[4 * i + 1], acc[4 * i + 2], acc[4 * i + 3]};
    }
    __syncthreads();
}
__device__ __forceinline__ void ret_scan(Frame& F, const float* KV, bf16* PREV) {
    LAUNDER(F);
    const int gt = F.vcu * (NWAVES * 64) + F.tid, NT = F.G * NWAVES * 64;
    for (int idx = gt; idx < BATCH * 4 * 8192; idx += NT) {
        const int de = idx & 8191, h = (idx >> 13) & 3, b = idx >> 15;
        const float cd = __expf(128.0f * ret_log_gamma(h));
        float s0 = 0.f, s1 = 0.f;
        const size_t base = ((size_t)(b * 32) * 4 + h) * 16384 + 2 * de;
#pragma unroll 8
        for (int n = 0; n < 32; ++n) {
            const size_t off = base + (size_t)n * 65536;
            const float p0 = cd * s0, p1 = cd * s1;
            *(GAS unsigned*)(PREV + off) = pk2(p0, p1);
            typedef float f32x2_t __attribute__((ext_vector_type(2))); const f32x2_t kv = *(const GAS f32x2_t*)(KV + off);
            s0 = p0 + kv.x; s1 = p1 + kv.y;
        }
    }
}
__device__ __forceinline__ void ret_out_simple(Frame& F, int layer, const bf16* PROJ, const bf16* PREV, bf16* MIX) {
    LAUNDER(F);
    LAS unsigned short* kd = (LAS unsigned short*)(F.lds + RING_OFF);
    LAS unsigned short* vv = (LAS unsigned short*)(F.lds + RING_OFF + 32768);
    LAS unsigned short* pv = (LAS unsigned short*)(F.lds + RING_OFF + 65536);
    LAS unsigned short* qd = (LAS unsigned short*)(F.lds + RING_OFF + 98304);
    const float* gain = F.rng + layer * 512;
    const int tid = F.tid;
    for (int u = F.vcu; u < 512; u += F.G) {
        const int h = u & 3, bn = u >> 2; const size_t row0 = (size_t)bn * 128;
        const float lg = ret_log_gamma(h);
        __syncthreads();
        { const int r = tid >> 2, part = tid & 3;
          const bf16* kp = PROJ + (row0 + r) * NIN + C_RK + h * 128 + part * 32;
          const bf16* vp = PROJ + (row0 + r) * NIN + C_RV + h * 128 + part * 32;
          const bf16* qp = PROJ + (row0 + r) * NIN + C_RQ + h * 128 + part * 32;
          const bf16* pp = PREV + ((size_t)u * 128 + r) * 128 + part * 32;
          const float dk = __expf(lg * (float)(127 - r)) * 0.08838834764831845f;
          const float dq = __expf(lg * (float)(r - 127));
#pragma unroll
          for (int i = 0; i < 4; ++i) { const v4u w = *(const GAS v4u*)(kp + 8 * i); float f[8]; unpack8(w, f);
              v4u o; o.x = pk2(f[0] * dk, f[1] * dk); o.y = pk2(f[2] * dk, f[3] * dk); o.z = pk2(f[4] * dk, f[5] * dk); o.w = pk2(f[6] * dk, f[7] * dk);
              *(LAS v4u*)(kd + r * 128 + part * 32 + 8 * i) = o;
              const v4u wq = *(const GAS v4u*)(qp + 8 * i); unpack8(wq, f);
              o.x = pk2(f[0] * dq, f[1] * dq); o.y = pk2(f[2] * dq, f[3] * dq); o.z = pk2(f[4] * dq, f[5] * dq); o.w = pk2(f[6] * dq, f[7] * dq);
              *(LAS v4u*)(qd + r * 128 + part * 32 + 8 * i) = o;
              *(LAS v4u*)(vv + r * 128 + part * 32 + 8 * i) = *(const GAS v4u*)(vp + 8 * i);
              *(LAS v4u*)(pv + r * 128 + part * 32 + 8 * i) = *(const GAS v4u*)(pp + 8 * i); }
        }
        __syncthreads();
        const int i_ = tid >> 2, p = tid & 3; const int i_hi = (tid >> 6) * 16 + 15;
        float qpart[32], o[32];
#pragma unroll
        for (int i = 0; i < 4; ++i) { const v4u w = *(const LAS v4u*)(qd + i_ * 128 + p * 32 + 8 * i); unpack8(w, qpart + 8 * i); }
#pragma unroll
        for (int e = 0; e < 32; ++e) o[e] = 0.f;
        for (int j = 0; j <= i_hi; ++j) {
            float dot = 0.f;
#pragma unroll
            for (int i = 0; i < 4; ++i) { const v4u w = *(const LAS v4u*)(kd + j * 128 + p * 32 + 8 * i); float f[8]; unpack8(w, f);
#pragma unroll
                for (int e = 0; e < 8; ++e) dot += qpart[8 * i + e] * f[e]; }
            dot += __shfl_xor(dot, 1); dot += __shfl_xor(dot, 2);
            const float s = (j <= i_) ? dot : 0.f;
#pragma unroll
            for (int i = 0; i < 4; ++i) { const v4u w = *(const LAS v4u*)(vv + j * 128 + p * 32 + 8 * i); float f[8]; unpack8(w, f);
#pragma unroll
                for (int e = 0; e < 8; ++e) o[8 * i + e] += s * f[e]; }
        }
        for (int d = 0; d < 128; ++d) {
            const float qv = bf2f(qd[i_ * 128 + d]);
#pragma unroll
            for (int i = 0; i < 4; ++i) { const v4u w = *(const LAS v4u*)(pv + d * 128 + p * 32 + 8 * i); float f[8]; unpack8(w, f);
#pragma unroll
                for (int e = 0; e < 8; ++e) o[8 * i + e] += qv * f[e]; }
        }
        float s1 = 0.f;
#pragma unroll
        for (int e = 0; e < 32; ++e) s1 += o[e];
        s1 += __shfl_xor(s1, 1); s1 += __shfl_xor(s1, 2);
        const float mu = s1 * (1.0f / 128.0f);
        float s2 = 0.f;
#pragma unroll
        for (int e = 0; e < 32; ++e) { o[e] -= mu; s2 += o[e] * o[e]; }
        s2 += __shfl_xor(s2, 1); s2 += __shfl_xor(s2, 2);
        const float rstd = 1.0f / sqrtf(s2 * (1.0f / 128.0f) + EPS);
        const bf16* gp = PROJ + (row0 + i_) * NIN + C_RG + h * 128 + p * 32;
        bf16* op = MIX + (row0 + i_) * D + 512 + h * 128 + p * 32;
        const float* gn = gain + h * 128 + p * 32;
#pragma unroll
        for (int i = 0; i < 4; ++i) { const v4u w = *(const GAS v4u*)(gp + 8 * i); float f[8]; unpack8(w, f); float r[8];
#pragma unroll
            for (int e = 0; e < 8; ++e) { const float gv = f[e]; r[e] = (gv / (1.0f + __expf(-gv))) * (o[8 * i + e] * rstd) * gn[8 * i + e]; }
            v4u ow; ow.x = pk2(r[0], r[1]); ow.y = pk2(r[2], r[3]); ow.z = pk2(r[4], r[5]); ow.w = pk2(r[6], r[7]);
            *(GAS v4u*)(op + 8 * i) = ow; }
    }
    __syncthreads();
}

struct Args { const float* in[14]; float* out; unsigned char* ws; int ph_lo, ph_hi, li, pad; };
__global__ void __launch_bounds__(NWAVES * 64, 2) fwd(Args args) {
    extern __shared__ __attribute__((aligned(16))) unsigned char lds[];
    Frame F;
    F.lds = (LAS unsigned char*)lds;
    F.MISC = (volatile LAS unsigned*)(F.lds + MISC_OFF);
    F.tid = threadIdx.x; F.lane = F.tid & 63; F.wave = __builtin_amdgcn_readfirstlane(F.tid >> 6);
    F.G = gridDim.x; { const int bx = blockIdx.x; F.vcu = (F.G % 8 == 0) ? (bx % 8) * (F.G / 8) + bx / 8 : bx; }
    unsigned char* ws = args.ws; F.ws = ws;
    F.ctl = (gu32*)(ws + WS_CTL);
    F.x = args.in[0]; F.c = args.in[1]; F.n1g = args.in[2]; F.n2g = args.in[3]; F.w_ada = args.in[4]; F.b_ada = args.in[5]; F.w_in = args.in[6];
    F.qng = args.in[7]; F.kng = args.in[8]; F.sinks = args.in[9]; F.rng = args.in[10]; F.w_out = args.in[11]; F.w_1 = args.in[12]; F.w_2 = args.in[13];
    F.out = args.out; F.ada = (float*)(ws + WS_ADA);
    for (int u = F.tid; u < (LDS_BYTES - LDSCTL_OFF) / 4; u += NWAVES * 64) ((LAS unsigned*)(F.lds + LDSCTL_OFF))[u] = 0u;
    __syncthreads();
    XcdBarrier bar; bar.bar = (unsigned*)(F.ctl + CW_BAR); bar.x = 0; bar.st = nullptr;
    if (N_LAUNCHES == 1) bar = xcd_barrier_post((unsigned*)(F.ctl + CW_BAR), F.MISC + 8);
#define GRID_BAR() do { if (N_LAUNCHES == 1) { xcd_barrier(bar); } } while (0)
    const int lo = args.ph_lo, hi = args.ph_hi;
#define IN(k) (lo <= (k) && (k) < hi)
#define BOTH(k) (IN(k) && IN((k) + 1))
    bf16* XN = (bf16*)(ws + WS_XN); bf16* PROJ = (bf16*)(ws + WS_PROJ); bf16* MIX = (bf16*)(ws + WS_MIX); bf16* HB = (bf16*)(ws + WS_H);
    float* KV = (float*)(ws + WS_KV); bf16* PREV = (bf16*)(ws + WS_PREV);

    if (IN(0)) { p0_prologue(F); if (BOTH(0)) GRID_BAR(); }
#pragma unroll 1
    for (int l = 0; l < NLAYER; ++l) {
        const int pb = 1 + PH_PER_LAYER * l;
        const float* xin = (l == 0) ? F.x : (const float*)F.out;
        const float* ada_l = F.ada + (size_t)l * BATCH * ADA;
        const bf16* wl = (const bf16*)(ws + WS_W + (size_t)l * W_LAYER);
        if (IN(pb + 0)) { xn_phase(F, xin, F.n1g + l * D, ada_l + 0 * D, ada_l + 1 * D, XN); if (BOTH(pb + 0)) GRID_BAR(); }
        if (IN(pb + 1)) {
            pg8::Gemm g{XN, wl + WO_IN / 2, M, NIN, D}; pg8::StaticOrder S; S.init(M, NIN, F.G, (int)blockIdx.x);
            pg8::EpiBf16<0> E{PROJ, NIN};
            pg8::gemm_phase<pg8::EpiBf16<0>, pg8::StaticOrder, PG8_ALIGN, PG8_SP2>(F.lds + RING_OFF, g, S, E);
            if (BOTH(pb + 1)) GRID_BAR();
        }
        if (IN(pb + 2)) { attn_simple(F, l, PROJ, MIX); ret_kv_simple(F, PROJ, KV); if (BOTH(pb + 2)) GRID_BAR(); }
        if (IN(pb + 3)) { ret_scan(F, KV, PREV); if (BOTH(pb + 3)) GRID_BAR(); }
        if (IN(pb + 4)) { ret_out_simple(F, l, PROJ, PREV, MIX); if (BOTH(pb + 4)) GRID_BAR(); }
        if (IN(pb + 5)) {
            pg8::Gemm g{MIX, wl + WO_OUT / 2, M, D, D}; pg8::StaticOrder S; S.init(M, D, F.G, (int)blockIdx.x);
            pg8::EpiResGate E{xin, F.out, D, ada_l + 2 * D, ADA, SEQ};
            pg8::gemm_phase<pg8::EpiResGate, pg8::StaticOrder, PG8_ALIGN, PG8_SP2>(F.lds + RING_OFF, g, S, E);
            if (BOTH(pb + 5)) GRID_BAR();
        }
        if (IN(pb + 6)) { xn_phase(F, F.out, F.n2g + l * D, ada_l + 3 * D, ada_l + 4 * D, XN); if (BOTH(pb + 6)) GRID_BAR(); }
        if (IN(pb + 7)) {
            pg8::Gemm g{XN, wl + WO_1 / 2, M, FF, D}; pg8::StaticOrder S; S.init(M, FF, F.G, (int)blockIdx.x);
            pg8::EpiBf16<1> E{HB, FF};
            pg8::gemm_phase<pg8::EpiBf16<1>, pg8::StaticOrder, PG8_ALIGN, PG8_SP2>(F.lds + RING_OFF, g, S, E);
            if (BOTH(pb + 7)) GRID_BAR();
        }
        if (IN(pb + 8)) {
            pg8::Gemm g{HB, wl + WO_2 / 2, M, D, FF}; pg8::StaticOrder S; S.init(M, D, F.G, (int)blockIdx.x);
            pg8::EpiResGate E{F.out, F.out, D, ada_l + 5 * D, ADA, SEQ};
            pg8::gemm_phase<pg8::EpiResGate, pg8::StaticOrder, PG8_ALIGN, PG8_SP2>(F.lds + RING_OFF, g, S, E);
            if (BOTH(pb + 8)) GRID_BAR();
        }
    }
#undef IN
#undef BOTH
}

extern "C" void kernel_launch(void* const* d_in, const int* in_sizes, int n_in, void* d_out, int out_size, void* d_ws, size_t ws_size, hipStream_t stream) {
    static int grid = 0;
    if (grid == 0) {
        if (n_in != 14 || in_sizes[0] != M * D || out_size != M * D || ws_size < WS_END) { fprintf(stderr, "kernel_launch: unexpected shapes (n_in %d, in0 %d, out %d, ws %zu); nothing launched\n", n_in, n_in > 0 ? in_sizes[0] : -1, out_size, ws_size); grid = -1; return; }
        int dev = 0, cus = 0, per_cu = 0;
        if (hipGetDevice(&dev) != hipSuccess || hipDeviceGetAttribute(&cus, hipDeviceAttributeMultiprocessorCount, dev) != hipSuccess) { grid = -1; return; }
        if (hipFuncSetAttribute((const void*)fwd, hipFuncAttributeMaxDynamicSharedMemorySize, LDS_BYTES) != hipSuccess) { fprintf(stderr, "kernel_launch: hipFuncSetAttribute failed\n"); grid = -1; return; }
        if (hipOccupancyMaxActiveBlocksPerMultiprocessor(&per_cu, (const void*)fwd, NWAVES * 64, LDS_BYTES) != hipSuccess || per_cu < 1) { fprintf(stderr, "kernel_launch: occupancy query reports %d blocks per CU\n", per_cu); }
        (void)hipGetLastError();
        grid = cus;
    }
    if (grid < 0) return;
    if (hipMemsetAsync((char*)d_ws + WS_CTL, 0, CTL_ZERO_BYTES, stream) != hipSuccess) { fprintf(stderr, "kernel_launch: hipMemsetAsync failed\n"); return; }
    Args a{};
    for (int i = 0; i < 14; ++i) a.in[i] = (const float*)d_in[i];
    a.out = (float*)d_out; a.ws = (unsigned char*)d_ws;
    for (int li = 0; li < N_LAUNCHES; ++li) {
        a.ph_lo = (N_LAUNCHES == 1) ? 0 : li; a.ph_hi = (N_LAUNCHES == 1) ? NPHASE : li + 1; a.li = li;
        hipLaunchKernelGGL(fwd, dim3(grid), dim3(NWAVES * 64), LDS_BYTES, stream, a);
        const hipError_t le = hipPeekAtLastError();
        if (le != hipSuccess) { fprintf(stderr, "kernel_launch: launch %d failed: %s\n", li, hipGetErrorName(le)); break; }
    }
}
```

```cpp
#include <hip/hip_runtime.h>
#include <cstdio>
#include <cstdint>
namespace pg8 {
#define PG8_LAS __attribute__((address_space(3)))
typedef unsigned short bf16_t;
typedef short bf16x8 __attribute__((ext_vector_type(8)));
typedef float f32x4 __attribute__((ext_vector_type(4)));
typedef unsigned u32x4 __attribute__((ext_vector_type(4)));
constexpr int BM = 256, BK = 64, HALF = 128, HTB = HALF * BK * 2  , STAGE_BYTES = 8 * HTB, NXCD = 8, WGM = 8;

__host__ __device__ __forceinline__ int lds_byte(int r, int c) { const int st = (r >> 4) * 2 + (c >> 5), rr = r & 15, cc = c & 31, ob = rr * 64 + cc * 2; return st * 1024 + (ob ^ (((ob >> 9) & 1) << 5)); }
__host__ __device__ __forceinline__ void stage_rc(int b, int& R, int& C) { const int st = b / 1024, sb = b % 1024, swz = sb ^ (((sb >> 9) & 1) << 5); R = (st >> 1) * 16 + swz / 64; C = (st & 1) * 32 + (swz % 64) / 2; }
__host__ __device__ __forceinline__ int perm32(int rho) { const int n = rho >> 4, i = rho & 15; return 8 * (i >> 2) + 4 * n + (i & 3); }

struct Unit { int pm, pn; };
struct Gemm { const bf16_t* A; const bf16_t* Bt; int M, N, K; unsigned a_panel_bytes; };

struct StaticOrder {
    int nM, nN, nwg, G, c;
    __host__ __device__ void init(int M, int N, int G_, int c_) { nM = M / BM; nN = N / BM; nwg = nM * nN; G = G_; c = c_; }
    __host__ __device__ bool next(int i, Unit& u) const {
        const long L = (long)i * G + c; if (L >= nwg) return false;
        int wgid = (int)L; { const int q = nwg / NXCD, r = nwg % NXCD, xcd = wgid % NXCD, off = wgid / NXCD; wgid = (xcd < r ? xcd * (q + 1) : r * (q + 1) + (xcd - r) * q) + off; }
        const int nig = WGM * nN, gid = wgid / nig, fm = gid * WGM, gsz = (nM - fm) < WGM ? (nM - fm) : WGM;
        u.pm = fm + ((wgid % nig) % gsz); u.pn = (wgid % nig) / gsz; return true;
    }
    __device__ __forceinline__ void a_ready(const Unit&) const {}
    __device__ __forceinline__ void done(const Unit&) const {}
};


struct TeamOrder {
    int pm, pn0, cnt;
    __device__ __forceinline__ bool next(int i, Unit& u) const { if (i >= cnt) return false; u.pm = pm; u.pn = pn0 + i; return true; }
    __device__ __forceinline__ void a_ready(const Unit&) const {}
    __device__ __forceinline__ void done(const Unit&) const {}
};
__device__ __forceinline__ unsigned cvt_pk_bf16(float lo, float hi) { unsigned r; asm volatile("v_cvt_pk_bf16_f32 %0, %1, %2" : "=v"(r) : "v"(lo), "v"(hi)); return r; }

constexpr float ADA_FX = 16777216.0f, ADA_IFX = 1.0f / 16777216.0f, SSQ_FX = 4096.0f, SSQ_IFX = 1.0f / 4096.0f;
typedef int i32x4 __attribute__((ext_vector_type(4)));
__device__ __forceinline__ f32x4 ld_ada4(const float* p) { const i32x4 v = *(const i32x4*)p; return (f32x4){(float)v.x, (float)v.y, (float)v.z, (float)v.w} * ADA_IFX; }
typedef unsigned u32x2_t __attribute__((ext_vector_type(2)));
#ifndef PG8_ST_AUX
#define PG8_ST_AUX 0
#endif
#ifndef PG8_RES_AUX
#define PG8_RES_AUX 0
#endif
#define PG8_RSRC(p) __builtin_amdgcn_make_buffer_rsrc((void*)(p), 0, 0x7ffffff0, 0x00020000)
__device__ __forceinline__ void st16_wt(__amdgpu_buffer_rsrc_t r, unsigned byte_off, u32x4 v) { __builtin_amdgcn_raw_buffer_store_b128(v, r, byte_off, 0, PG8_ST_AUX); }
__device__ __forceinline__ void st8_wt(__amdgpu_buffer_rsrc_t r, unsigned byte_off, u32x2_t v) { __builtin_amdgcn_raw_buffer_store_b64(v, r, byte_off, 0, PG8_ST_AUX); }
template <int ACT  , int NORM> struct EpiBf16 {
    static constexpr bool PERM = true, AFTER_DRAIN = false;
    bf16_t* O; int ldc; const float* ssq; const float* sw; int sw_bstride; int rows_per_batch; float inv_n, eps; unsigned o_panel_elems;
    __device__ __forceinline__ void operator()(const f32x4 (&acc)[2][2][4][2], const Unit& u, int wr, int wc, int fr_in, int fq_in) const {
        int fr = fr_in, fq = fq_in; asm volatile("" : "+v"(fr), "+v"(fq));
        const int row0 = u.pm * BM + wr * 64 + fr; const int col0 = u.pn * BM + wc * 32 + 8 * fq;
        const __amdgpu_buffer_rsrc_t rO = PG8_RSRC(O);
        f32x4 sv[2][2];
        if (NORM) { const float* sp = sw + (size_t)((u.pm * BM) / rows_per_batch) * sw_bstride + col0;
#pragma unroll
            for (int bj = 0; bj < 2; ++bj) { sv[bj][0] = *(const f32x4*)(sp + bj * HALF); sv[bj][1] = *(const f32x4*)(sp + bj * HALF + 4); } }
#pragma unroll
        for (int ai = 0; ai < 2; ++ai)
#pragma unroll
            for (int m = 0; m < 4; ++m) { const int row = row0 + ai * HALF + m * 16; const unsigned rowb = ((unsigned)u.pm * o_panel_elems + (unsigned)(row - u.pm * BM) * (unsigned)ldc + (unsigned)col0) * 2u;
                float rs = 1.f; if (NORM) rs = __builtin_amdgcn_rsqf((float)((const int*)ssq)[row] * (inv_n * SSQ_IFX) + eps);
#pragma unroll
                for (int bj = 0; bj < 2; ++bj) { f32x4 v0 = acc[ai][bj][m][0], v1 = acc[ai][bj][m][1];
                    if (NORM) { v0 = v0 * rs + sv[bj][0]; v1 = v1 * rs + sv[bj][1]; }
                    if (ACT == 1) {
#pragma unroll
                        for (int e = 0; e < 4; ++e) { const float a = fmaxf(v0[e], 0.f), b = fmaxf(v1[e], 0.f); v0[e] = a * a; v1[e] = b * b; } }
                    u32x4 w; w.x = cvt_pk_bf16(v0[0], v0[1]); w.y = cvt_pk_bf16(v0[2], v0[3]); w.z = cvt_pk_bf16(v1[0], v1[1]); w.w = cvt_pk_bf16(v1[2], v1[3]);
                    if (ai == 0 && m == 0 && bj == 0) asm volatile("s_waitcnt vmcnt(0)" ::: "memory");
                    st16_wt(rO, rowb + bj * HALF * 2, w); } }
    }
};
template <int XG, int BIN, int BOUT> struct EpiResGate {
    static constexpr bool PERM = true, AFTER_DRAIN = false;
    const void* base; void* out; int ldc; const float* gate; int gate_bstride; int rows_per_batch;
    bf16_t* xg; const float* ng; const float* scale; float* ssq; unsigned base_panel, out_panel;
    __device__ __forceinline__ void operator()(const f32x4 (&acc)[2][2][4][2], const Unit& u, int wr, int wc, int fr_in, int fq_in) const {
        int fr = fr_in, fq = fq_in; asm volatile("" : "+v"(fr), "+v"(fq));
        const int row0 = u.pm * BM + wr * 64 + fr, col0 = u.pn * BM + wc * 32 + 8 * fq, lane = fr + 16 * fq;
        const int b = (u.pm * BM) / rows_per_batch;
        const __amdgpu_buffer_rsrc_t rOut = PG8_RSRC(out), rXg = PG8_RSRC(xg);
        const float* gp = gate + (size_t)b * gate_bstride + col0;
        f32x4 gv[2][2], gm[2][2];
#pragma unroll
        for (int bj = 0; bj < 2; ++bj)
#pragma unroll
            for (int n = 0; n < 2; ++n) { gv[bj][n] = ld_ada4(gp + bj * HALF + n * 4);
                if (XG) gm[bj][n] = *(const f32x4*)(ng + col0 + bj * HALF + n * 4) * (ld_ada4(scale + (size_t)b * gate_bstride + col0 + bj * HALF + n * 4) + 1.0f); }
#pragma unroll
        for (int ai = 0; ai < 2; ++ai)
#pragma unroll
            for (int m = 0; m < 4; ++m) { const int row = row0 + ai * HALF + m * 16; const size_t off = (size_t)row * ldc + col0; float ss = 0.f;
                const size_t offb = (size_t)u.pm * base_panel + (size_t)(row - u.pm * BM) * ldc + col0, offo = (size_t)u.pm * out_panel + (size_t)(row - u.pm * BM) * ldc + col0;
#pragma unroll
                for (int bj = 0; bj < 2; ++bj) { f32x4 b0, b1;
                    if (BIN) { const u32x4 w = __builtin_nontemporal_load((const u32x4*)((const bf16_t*)base + offb + bj * HALF));
                        b0 = (f32x4){__uint_as_float(w.x << 16), __uint_as_float(w.x & 0xffff0000u), __uint_as_float(w.y << 16), __uint_as_float(w.y & 0xffff0000u)};
                        b1 = (f32x4){__uint_as_float(w.z << 16), __uint_as_float(w.z & 0xffff0000u), __uint_as_float(w.w << 16), __uint_as_float(w.w & 0xffff0000u)}; }
                    else { b0 = __builtin_nontemporal_load((const f32x4*)((const float*)base + offb + bj * HALF)); b1 = __builtin_nontemporal_load((const f32x4*)((const float*)base + offb + bj * HALF + 4)); }
                    const f32x4 o0 = b0 + gv[bj][0] * acc[ai][bj][m][0], o1 = b1 + gv[bj][1] * acc[ai][bj][m][1];
                    if (BOUT) { u32x4 w; w.x = cvt_pk_bf16(o0[0], o0[1]); w.y = cvt_pk_bf16(o0[2], o0[3]); w.z = cvt_pk_bf16(o1[0], o1[1]); w.w = cvt_pk_bf16(o1[2], o1[3]); __builtin_amdgcn_raw_buffer_store_b128(w, rOut, (unsigned)(offo + bj * HALF) * 2u, 0, PG8_RES_AUX); }
                    else { __builtin_amdgcn_raw_buffer_store_b128(__builtin_bit_cast(u32x4, o0), rOut, (unsigned)(offo + bj * HALF) * 4u, 0, 2); __builtin_amdgcn_raw_buffer_store_b128(__builtin_bit_cast(u32x4, o1), rOut, (unsigned)(offo + bj * HALF + 4) * 4u, 0, 2); }
                    if (XG) { ss += ((o0[0] * o0[0] + o0[1] * o0[1]) + (o0[2] * o0[2] + o0[3] * o0[3])) + ((o1[0] * o1[0] + o1[1] * o1[1]) + (o1[2] * o1[2] + o1[3] * o1[3]));
                        const f32x4 g0 = o0 * gm[bj][0], g1 = o1 * gm[bj][1];
                        u32x4 w; w.x = cvt_pk_bf16(g0[0], g0[1]); w.y = cvt_pk_bf16(g0[2], g0[3]); w.z = cvt_pk_bf16(g1[0], g1[1]); w.w = cvt_pk_bf16(g1[2], g1[3]);
                        st16_wt(rXg, (unsigned)(off + bj * HALF) * 2u, w); } }
                if (XG) { ss += __int_as_float(__builtin_amdgcn_ds_bpermute((lane ^ 16) << 2, __float_as_int(ss))); ss += __int_as_float(__builtin_amdgcn_ds_bpermute((lane ^ 32) << 2, __float_as_int(ss)));
                    if (fq == 0) atomicAdd((int*)ssq + row, __float2int_rn(ss * SSQ_FX)); } }
    }
};

template <class Epi, class Sched, bool ALIGN_EPI = false, bool SP2 = false>
__device__ __forceinline__ void gemm_phase(PG8_LAS unsigned char* lds, const Gemm g, const Sched& S, const Epi& E, int wave_id  ) {
    int tid_l; asm volatile("v_mbcnt_lo_u32_b32 %0, -1, 0\n\tv_mbcnt_hi_u32_b32 %0, -1, %0" : "=v"(tid_l)); tid_l += wave_id * 64;
    const int tid = tid_l, wid = wave_id, lane = tid & 63, wr = wid >> 2, wc = wid & 3, fr = lane & 15, fq = lane >> 4;
    const int K = g.K, nt = K / BK;
    unsigned voffA[2], voffB[2];
#pragma unroll
    for (int i = 0; i < 2; ++i) { int R, C; stage_rc(tid * 16 + i * 8192, R, C); const int Rb = Epi::PERM ? ((R & ~31) + perm32(R & 31)) : R;
        voffA[i] = (unsigned)(R * K + C) * 2u; voffB[i] = (unsigned)(Rb * K + C) * 2u; }
    const unsigned kstep = (unsigned)(BK * 2);
    const unsigned hstep = (unsigned)HALF * K * 2;
    const unsigned tstep = 2 * hstep;
    const unsigned ldsw = (unsigned)wid * 1024u;
    const int aoff = lds_byte(wr * 64 + fr, fq * 8), boff = lds_byte(wc * 32 + fr, fq * 8);
#define PG8_SA(b, h) (((b) * 2 + (h)) * HTB)
#define PG8_SB(b, h) ((4 + (b) * 2 + (h)) * HTB)
    const __amdgpu_buffer_rsrc_t rsrc_voffA = __builtin_amdgcn_make_buffer_rsrc((void*)g.A, 0, 0x7ffffff0, 0x00020000), rsrc_voffB = __builtin_amdgcn_make_buffer_rsrc((void*)g.Bt, 0, 0x7ffffff0, 0x00020000);
#ifndef PG8_A_AUX
#define PG8_A_AUX 0
#endif
#ifndef PG8_B_AUX
#define PG8_B_AUX 0
#endif
    constexpr int aux_voffA = PG8_A_AUX, aux_voffB = PG8_B_AUX;
#define PG8_STAGE(bufoff, goff, voff) do { _Pragma("unroll") for (int _i = 0; _i < 2; ++_i) \
        __builtin_amdgcn_raw_ptr_buffer_load_lds(rsrc_##voff, (PG8_LAS unsigned*)(lds + (bufoff) + ldsw + _i * 8192), 16, (voff)[_i], (goff), 0, aux_##voff); } while (0)
#define PG8_LDA(dst, b, h) do { _Pragma("unroll") for (int m = 0; m < 4; ++m) _Pragma("unroll") for (int k = 0; k < 2; ++k) dst[m][k] = *(const PG8_LAS bf16x8*)(lds + PG8_SA(b, h) + aoff + m * 2048 + k * 1024); } while (0)
#define PG8_LDB(dst, b, h) do { _Pragma("unroll") for (int n = 0; n < 2; ++n) _Pragma("unroll") for (int k = 0; k < 2; ++k) dst[n][k] = *(const PG8_LAS bf16x8*)(lds + PG8_SB(b, h) + boff + n * 2048 + k * 1024); } while (0)
#define PG8_MMA(ai, bj, At, Bt) do { __builtin_amdgcn_s_setprio(1); _Pragma("unroll") for (int m = 0; m < 4; ++m) _Pragma("unroll") for (int n = 0; n < 2; ++n) _Pragma("unroll") for (int k = 0; k < 2; ++k) \
        acc[ai][bj][m][n] = __builtin_amdgcn_mfma_f32_16x16x32_bf16(Bt[n][k], At[m][k], acc[ai][bj][m][n], 0, 0, 0); __builtin_amdgcn_s_setprio(0); } while (0)
#define PG8_WAIT_V(n) asm volatile("s_waitcnt vmcnt(" #n ")" ::: "memory")
#define PG8_WAIT_L(n) asm volatile("s_waitcnt lgkmcnt(" #n ")" ::: "memory")
#define PG8_BAR __builtin_amdgcn_s_barrier()
#define PG8_SCHED __builtin_amdgcn_sched_barrier(0)
#define PG8_ITER_SP2(ST11, WV) do { \
            PG8_LDB(B0, 0, 0); PG8_LDB(B1, 0, 1); PG8_SCHED; PG8_LDA(At, 0, 0); ST11; \
            WV; PG8_WAIT_L(0); PG8_BAR; PG8_MMA(0, 0, At, B0); PG8_MMA(0, 1, At, B1); PG8_BAR; PG8_SCHED; \
            PG8_LDA(At, 0, 1); PG8_STAGE(PG8_SB(0, 0), b2, voffB); PG8_STAGE(PG8_SB(0, 1), b2 + hstep, voffB); PG8_STAGE(PG8_SA(0, 0), a2, voffA); \
            WV; PG8_WAIT_L(0); PG8_BAR; PG8_MMA(1, 0, At, B0); PG8_MMA(1, 1, At, B1); PG8_BAR; PG8_SCHED; \
            PG8_LDB(B0, 1, 0); PG8_LDB(B1, 1, 1); PG8_SCHED; PG8_LDA(At, 1, 0); PG8_STAGE(PG8_SA(0, 1), a2 + hstep, voffA); \
            WV; PG8_WAIT_L(0); PG8_BAR; PG8_MMA(0, 0, At, B0); PG8_MMA(0, 1, At, B1); PG8_BAR; PG8_SCHED; \
            PG8_LDA(At, 1, 1); PG8_STAGE(PG8_SB(1, 0), b3, voffB); PG8_STAGE(PG8_SB(1, 1), b3 + hstep, voffB); PG8_STAGE(PG8_SA(1, 0), a3, voffA); \
            PG8_WAIT_V(8); PG8_WAIT_L(0); PG8_BAR; PG8_MMA(1, 0, At, B0); PG8_MMA(1, 1, At, B1); PG8_BAR; PG8_SCHED; } while (0)
    Unit cur, nxt; int ui = 0;
    if (!S.next(0, cur)) return;
    f32x4 acc[2][2][4][2];
#pragma unroll
    for (int a = 0; a < 2; ++a)
#pragma unroll
        for (int b = 0; b < 2; ++b)
#pragma unroll
            for (int m = 0; m < 4; ++m)
#pragma unroll
                for (int n = 0; n < 2; ++n) acc[a][b][m][n] = (f32x4){0.f, 0.f, 0.f, 0.f};
    bf16x8 At[4][2], B0[2][2], B1[2][2];
    unsigned cA = (unsigned)cur.pm * g.a_panel_bytes, cB = (unsigned)cur.pn * tstep;
    S.a_ready(cur);
    if constexpr (SP2) {
        PG8_STAGE(PG8_SB(0, 0), cB, voffB); PG8_STAGE(PG8_SB(0, 1), cB + hstep, voffB); PG8_STAGE(PG8_SA(0, 0), cA, voffA); PG8_STAGE(PG8_SA(0, 1), cA + hstep, voffA);
        if (wr == 1) PG8_BAR;
        PG8_WAIT_V(2); PG8_BAR;
        PG8_STAGE(PG8_SB(1, 0), cB + kstep, voffB); PG8_STAGE(PG8_SA(1, 0), cA + kstep, voffA); PG8_STAGE(PG8_SB(1, 1), cB + hstep + kstep, voffB);
        PG8_WAIT_V(6); PG8_BAR;
    } else {
        PG8_STAGE(PG8_SB(0, 0), cB, voffB); PG8_STAGE(PG8_SA(0, 0), cA, voffA); PG8_STAGE(PG8_SB(0, 1), cB + hstep, voffB); PG8_STAGE(PG8_SA(0, 1), cA + hstep, voffA);
        if (wr == 1) PG8_BAR;
        PG8_WAIT_V(4); PG8_BAR;
        PG8_STAGE(PG8_SB(1, 0), cB + kstep, voffB); PG8_STAGE(PG8_SA(1, 0), cA + kstep, voffA); PG8_STAGE(PG8_SB(1, 1), cB + hstep + kstep, voffB);
        PG8_WAIT_V(6); PG8_BAR;
    }
    for (;;) {
        const bool has_next = S.next(ui + 1, nxt);
        const unsigned nA = has_next ? (unsigned)nxt.pm * g.a_panel_bytes : cA, nB = has_next ? (unsigned)nxt.pn * tstep : cB;
        int t = 0;
        if constexpr (SP2 && ALIGN_EPI) {
            if (ui > 0) { const unsigned a2 = cA + 2u * kstep, b2 = cB + 2u * kstep, a3 = a2 + kstep, b3 = b2 + kstep;
                PG8_ITER_SP2((void)0, (void)0); t = 2; }
        }
        for (; t < nt; t += 2) {
            const bool last = (t == nt - 2);
            const unsigned a1 = cA + (unsigned)(t + 1) * kstep;
            const unsigned a2 = last ? nA : cA + (unsigned)(t + 2) * kstep, b2 = last ? nB : cB + (unsigned)(t + 2) * kstep;
            const unsigned a3 = a2 + kstep, b3 = b2 + kstep;
            if (last && has_next) S.a_ready(nxt);
            if constexpr (SP2) {
            PG8_ITER_SP2(PG8_STAGE(PG8_SA(1, 1), a1 + hstep, voffA), PG8_WAIT_V(8));
            } else {
            PG8_LDB(B0, 0, 0); PG8_SCHED; PG8_LDA(At, 0, 0); PG8_STAGE(PG8_SA(1, 1), a1 + hstep, voffA);
            PG8_WAIT_L(8); PG8_BAR; PG8_WAIT_L(0); PG8_MMA(0, 0, At, B0); PG8_BAR; PG8_SCHED;
            PG8_LDB(B1, 0, 1); PG8_STAGE(PG8_SB(0, 0), b2, voffB);
            PG8_BAR; PG8_WAIT_L(0); PG8_MMA(0, 1, At, B1); PG8_BAR;
            PG8_LDA(At, 0, 1); PG8_STAGE(PG8_SA(0, 0), a2, voffA);
            PG8_BAR; PG8_WAIT_L(0); PG8_MMA(1, 0, At, B0); PG8_BAR; PG8_SCHED;
            PG8_STAGE(PG8_SB(0, 1), b2 + hstep, voffB);
            PG8_WAIT_V(6); PG8_BAR; PG8_MMA(1, 1, At, B1); PG8_BAR;
            PG8_LDB(B0, 1, 0); PG8_SCHED; PG8_LDA(At, 1, 0); PG8_STAGE(PG8_SA(0, 1), a2 + hstep, voffA);
            PG8_WAIT_L(8); PG8_BAR; PG8_WAIT_L(0); PG8_MMA(0, 0, At, B0); PG8_BAR; PG8_SCHED;
            PG8_LDB(B1, 1, 1); PG8_STAGE(PG8_SB(1, 0), b3, voffB);
            PG8_BAR; PG8_WAIT_L(0); PG8_MMA(0, 1, At, B1); PG8_BAR;
            PG8_LDA(At, 1, 1); PG8_STAGE(PG8_SA(1, 0), a3, voffA);
            PG8_BAR; PG8_WAIT_L(0); PG8_MMA(1, 0, At, B0); PG8_BAR; PG8_SCHED;
            PG8_STAGE(PG8_SB(1, 1), b3 + hstep, voffB);
            PG8_WAIT_V(6); PG8_BAR; PG8_MMA(1, 1, At, B1); PG8_BAR;
            }
        }
        if constexpr (ALIGN_EPI) { if (wr == 0) PG8_BAR; }
        if constexpr (SP2 && ALIGN_EPI) { if (has_next) PG8_STAGE(PG8_SA(1, 1), nA + kstep + hstep, voffA); }
        if constexpr (!Epi::AFTER_DRAIN) { E(acc, cur, wr, wc, fr, fq); S.done(cur); }
        if (!has_next) break;
#pragma unroll
        for (int a = 0; a < 2; ++a)
#pragma unroll
            for (int b = 0; b < 2; ++b)
#pragma unroll
                for (int m = 0; m < 4; ++m)
#pragma unroll
                    for (int n = 0; n < 2; ++n) { acc[a][b][m][n] = (f32x4){0.f, 0.f, 0.f, 0.f}; asm volatile("" : "+v"(acc[a][b][m][n])); }
        cur = nxt; cA = nA; cB = nB; ++ui;
        if constexpr (ALIGN_EPI) { if (wr == 1) PG8_BAR; }
    }
    PG8_WAIT_V(0);
    if constexpr (!ALIGN_EPI) { if (wr == 0) PG8_BAR; }
    PG8_BAR;
    if constexpr (Epi::AFTER_DRAIN) { E.fused(acc, cur, wr, wc, fr, fq, lds, wid, lane); S.done(cur); }
#undef PG8_ITER_SP2
#undef PG8_SA
#undef PG8_SB
#undef PG8_STAGE
#undef PG8_LDA
#undef PG8_LDB
#undef PG8_MMA
#undef PG8_WAIT_V
#undef PG8_WAIT_L
#undef PG8_BAR
#undef PG8_SCHED
}
}

#ifndef PG8_SP2
#define PG8_SP2 true
#endif
#ifndef PG8_ALIGN
#define PG8_ALIGN true
#endif
constexpr int NWAVES = 8;
constexpr int BATCH = 4, SEQ = 4096, D = 1024, M = BATCH * SEQ, NIN = 2816, FF = 4096, NLAYER = 2, ADA = 6 * D;
constexpr int C_AQ = 0, C_AK = 512, C_AV = 640, C_RQ = 768, C_RK = 1280, C_RV = 1792, C_RG = 2304;
constexpr float EPS = 1e-6f;

constexpr size_t MiB = 1u << 20;
constexpr size_t WS_CTL = 0, CTL_ZERO_BYTES = 1 * MiB;
constexpr size_t WS_SW = 64 * 1024;
constexpr size_t WS_SSQ = 768 * 1024;
constexpr size_t WS_ADA = 512 * 1024;
constexpr size_t WS_W = 1 * MiB, W_LAYER = 47 * MiB / 2;
constexpr size_t WO_IN = 0, WO_OUT = 11 * MiB / 2, WO_1 = 15 * MiB / 2, WO_2 = 31 * MiB / 2;
constexpr size_t WS_XN = 48 * MiB;
constexpr size_t WS_H = 80 * MiB;
constexpr size_t WS_PROJ = 80 * MiB;
constexpr size_t WS_MIX = WS_H + 256u * NIN * 2;
constexpr size_t WS_KV = 208 * MiB;
constexpr size_t WS_PREV = 240 * MiB;
constexpr size_t WS_END = 256 * MiB;
static_assert(WS_W + NLAYER * W_LAYER <= WS_XN && WS_XN + (size_t)M * D * 2 <= WS_H && WS_H + (size_t)M * FF * 2 <= WS_KV && WS_PREV + 512u * 16384 * 2 <= WS_END, "d_ws map");
constexpr int CW_TMO = 0, CW_CODE = 1;
constexpr int CW_BAR = 4096;
constexpr int CW_SWCNT = 320;
constexpr int CW_TEAM = 65536;
constexpr int CW_XCC = CW_TEAM + (NLAYER + 1) * 64 * 64;
constexpr int CW_XEV = 98304;
constexpr int CW_MIX = 8192;

constexpr int RING_OFF = 0, RING_BYTES = 131072;
constexpr int LDSCTL_OFF = RING_BYTES, MISC_OFF = LDSCTL_OFF + 320;
constexpr int RSTG_OFF = RING_BYTES + 1024;
constexpr int LDS_BYTES = 163840;
static_assert(MISC_OFF + 256 <= RSTG_OFF && RSTG_OFF + 8 * 2560 <= LDS_BYTES, "LDS map");

#define GAS __attribute__((address_space(1)))
#define LAS __attribute__((address_space(3)))
typedef unsigned short bf16;
typedef unsigned v4u __attribute__((ext_vector_type(4)));
typedef float f32x4 __attribute__((ext_vector_type(4)));
typedef short bf16x8 __attribute__((ext_vector_type(8)));
typedef GAS unsigned gu32;
typedef GAS unsigned long long gu64;
#define RLX_AGENT __ATOMIC_RELAXED, __HIP_MEMORY_SCOPE_AGENT
#define LDS_WAIT() asm volatile("s_waitcnt lgkmcnt(0)" ::: "memory")
#define VM_WAIT() asm volatile("s_waitcnt vmcnt(0)" ::: "memory")
__device__ __forceinline__ unsigned long long rt() { return __builtin_amdgcn_s_memrealtime(); }

__device__ __forceinline__ unsigned pk2(float lo, float hi) { typedef float f2_ __attribute__((ext_vector_type(2))); typedef __bf16 b2_ __attribute__((ext_vector_type(2))); f2_ v = {lo, hi}; b2_ b = __builtin_convertvector(v, b2_); return __builtin_bit_cast(unsigned, b); }
__device__ __forceinline__ unsigned f2bf(float f) { return pk2(f, f) & 0xffffu; }

#define XB_TMO      128
#define XB_XCNT(j)  (256  + 64 * (j))
#define XB_XSUB(j)  (1280 + 64 * (j))
#define XB_XGEN(j)  (2304 + 64 * (j))
#define XB_TOP      3328
#define XB_TOPGEN   3392
#define XCD_BAR_WORDS 3456
#define XB_SPIN_CAP (1u << 18)

__device__ __forceinline__ unsigned xb_ld(unsigned* p)              { return __hip_atomic_load(p, __ATOMIC_RELAXED, __HIP_MEMORY_SCOPE_AGENT); }
__device__ __forceinline__ unsigned xb_add(unsigned* p, unsigned v) { return __hip_atomic_fetch_add(p, v, __ATOMIC_RELAXED, __HIP_MEMORY_SCOPE_AGENT); }
__device__ __forceinline__ unsigned xb_xcc_id() { return (unsigned)__builtin_amdgcn_s_getreg((3 << 11) | 20) & 0xFu; }
#define XB_SPIN(cond, bar) do { unsigned _sp = 0; while (cond) { __builtin_amdgcn_s_sleep(1); \
    if ((++_sp & 255u) == 0u) { if (xb_ld(&(bar)[XB_TMO])) break; if (_sp > XB_SPIN_CAP) { atomicAdd(&(bar)[XB_TMO], 1u); break; } } } } while (0)

struct XcdBarrier {
    unsigned* bar; unsigned x;
    volatile LAS unsigned* st;
};

__device__ __forceinline__ XcdBarrier xcd_barrier_post(unsigned* bar, volatile LAS unsigned* st, int tid) {
    XcdBarrier b; b.bar = bar; b.x = xb_xcc_id(); b.st = st;
    if (tid == 0) (void)xb_add(&bar[XB_XCNT(b.x)], 1u);
    return b;
}
__device__ __forceinline__ void xcd_barrier_complete(unsigned* bar, unsigned x, unsigned& nloc, unsigned& nx) {
    const unsigned G = gridDim.x * gridDim.y * gridDim.z;
    unsigned sum, cnt, mine, sp = 0u;
    for (;;) {
        sum = 0u; cnt = 0u; mine = 0u;
#pragma unroll
        for (unsigned j = 0; j < 16; ++j) { const unsigned c = xb_ld(&bar[XB_XCNT(j)]); sum += c; cnt += (c > 0u) ? 1u : 0u; mine = (j == x) ? c : mine; }
        if (sum == G) break;
        __builtin_amdgcn_s_sleep(1);
        if ((++sp & 255u) == 0u) { if (xb_ld(&bar[XB_TMO])) break; if (sp > XB_SPIN_CAP) { atomicAdd(&bar[XB_TMO], 1u); break; } }
    }
    nloc = mine > 0u ? mine : 1u; nx = cnt > 0u ? cnt : 1u;
}

__device__ __forceinline__ void xcd_barrier(const XcdBarrier& b, int tid) {
    asm volatile("s_waitcnt vmcnt(0)" ::: "memory");
    __syncthreads();
    if (tid == 0) {
        unsigned* bar = b.bar;
        __builtin_amdgcn_s_waitcnt(0);
        unsigned nloc = b.st[0], nx = b.st[1];
        if (nloc == 0u) { xcd_barrier_complete(bar, b.x, nloc, nx); b.st[0] = nloc; b.st[1] = nx; }
        const unsigned old = xb_add(&bar[XB_XSUB(b.x)], 1u);
        const unsigned gen = old / nloc;
        if (old + 1u == (gen + 1u) * nloc) {
            __builtin_amdgcn_fence(__ATOMIC_RELEASE, "agent");
            asm volatile("s_waitcnt vmcnt(0)" ::: "memory");
            const unsigned og = xb_add(&bar[XB_TOP], 1u);
            const unsigned tg = og / nx;
            if (og + 1u == (tg + 1u) * nx) xb_add(&bar[XB_TOPGEN], 1u);
            else XB_SPIN(xb_ld(&bar[XB_TOPGEN]) == tg, bar);
            __builtin_amdgcn_fence(__ATOMIC_ACQUIRE, "agent");
            xb_add(&bar[XB_XGEN(b.x)], 1u);
            asm volatile("s_waitcnt vmcnt(0)" ::: "memory");
        } else {
            XB_SPIN(xb_ld(&bar[XB_XGEN(b.x)]) == gen, bar);
            __builtin_amdgcn_fence(__ATOMIC_ACQUIRE, "agent");
            asm volatile("s_waitcnt vmcnt(0)" ::: "memory");
        }
    }
    __syncthreads();
}

struct Args { const float* in[14]; float* out; unsigned char* ws; };
typedef const __attribute__((address_space(4))) Args* ArgsP;
__device__ __forceinline__ ArgsP get_args() { ArgsP p = (ArgsP)__builtin_amdgcn_kernarg_segment_ptr(); asm volatile("" : "+s"(p)); return p; }
struct Frame {
    LAS unsigned char* lds;
    ArgsP ap;
    int tid, lane, wave;
    int vcu, G;
    int wave0, vcu0, G0;
};
#define F_X(F) ((F).ap->in[0])
#define F_C(F) ((F).ap->in[1])
#define F_N1G(F) ((F).ap->in[2])
#define F_N2G(F) ((F).ap->in[3])
#define F_WADA(F) ((F).ap->in[4])
#define F_BADA(F) ((F).ap->in[5])
#define F_WIN(F) ((F).ap->in[6])
#define F_QNG(F) ((F).ap->in[7])
#define F_KNG(F) ((F).ap->in[8])
#define F_SINKS(F) ((F).ap->in[9])
#define F_RNG(F) ((F).ap->in[10])
#define F_WOUT(F) ((F).ap->in[11])
#define F_W1(F) ((F).ap->in[12])
#define F_W2(F) ((F).ap->in[13])
#define F_OUT(F) ((F).ap->out)
#define F_WS(F) ((F).ap->ws)
#define F_ADA(F) ((float*)((F).ap->ws + WS_ADA))
#define LAUNDER(F) do { (F).ap = get_args(); int l_; asm volatile("v_mbcnt_lo_u32_b32 %0, -1, 0\n\tv_mbcnt_hi_u32_b32 %0, -1, %0" : "=v"(l_)); int w_ = (F).wave0, c_ = (F).vcu0, g_ = (F).G0; asm volatile("" : "+s"(w_), "+s"(c_), "+s"(g_)); (F).lane = l_; (F).wave = w_; (F).vcu = c_; (F).G = g_; (F).tid = w_ * 64 + l_; } while (0)
__device__ __forceinline__ float bf2f(unsigned short u) { return __uint_as_float(((unsigned)u) << 16); }
__device__ __forceinline__ float bflo(unsigned u) { return __uint_as_float(u << 16); }
__device__ __forceinline__ float bfhi(unsigned u) { return __uint_as_float(u & 0xffff0000u); }
__device__ __forceinline__ void unpack8(const v4u w, float* f) { f[0] = bflo(w.x); f[1] = bfhi(w.x); f[2] = bflo(w.y); f[3] = bfhi(w.y); f[4] = bflo(w.z); f[5] = bfhi(w.z); f[6] = bflo(w.w); f[7] = bfhi(w.w); }
__device__ __forceinline__ float shx(float v, int mask, int lane) { return __int_as_float(__builtin_amdgcn_ds_bpermute((lane ^ mask) << 2, __float_as_int(v))); }
__device__ __forceinline__ float wave_sum(float v, int lane) {
#pragma unroll
    for (int o = 1; o < 64; o <<= 1) v += shx(v, o, lane);
    return v;
}
__device__ __forceinline__ float ret_log_gamma(int h) { return h == 0 ? -0.031748698314580301f : h == 1 ? -0.015748356968139168f : h == 2 ? -0.0078431774610258928f : -0.0039138993211363287f; }

__device__ __forceinline__ void p0_transpose_item(const float* W, int K, int N, bf16* WT, int row_off, LAS float* scr, int item, int lane) {
    const int nblk = N / 32, kb = item / nblk, nb = item % nblk, k0 = 64 * kb, n0 = 32 * nb;
    f32x4 wv[8];
#pragma unroll
    for (int i = 0; i < 8; ++i) wv[i] = __builtin_nontemporal_load((const GAS f32x4*)(W + (size_t)(k0 + 8 * i + (lane >> 3)) * N + n0 + 4 * (lane & 7)));
#pragma unroll
    for (int i = 0; i < 8; ++i) { LAS float* d = scr + (8 * i + (lane >> 3)) * 33 + 4 * (lane & 7); d[0] = wv[i].x; d[1] = wv[i].y; d[2] = wv[i].z; d[3] = wv[i].w; }
    LDS_WAIT(); asm volatile("" ::: "memory");
    const int c = lane & 7;
#pragma unroll
    for (int j = 0; j < 4; ++j) { const int n = (lane >> 3) + 8 * j; const LAS float* s = scr + (8 * c) * 33 + n;
        v4u o; o.x = pk2(s[0 * 33], s[1 * 33]); o.y = pk2(s[2 * 33], s[3 * 33]); o.z = pk2(s[4 * 33], s[5 * 33]); o.w = pk2(s[6 * 33], s[7 * 33]);
        *(GAS v4u*)(WT + (size_t)(row_off + n0 + n) * K + k0 + 8 * c) = o; }
    LDS_WAIT(); asm volatile("" ::: "memory");
}
constexpr int ADA_KS = 32, ADA_NKS = D / ADA_KS, ADA_NCB = ADA / 256;
__device__ __forceinline__ void p0_ada_item(Frame& F, int item, LAS float* scr) {
    const int ks = item % ADA_NKS, cb = (item / ADA_NKS) % ADA_NCB, l = item / (ADA_NKS * ADA_NCB), k0 = ks * ADA_KS, j = cb * 256 + 4 * F.lane;
    const GAS f32x4* w = (const GAS f32x4*)(F_WADA(F) + ((size_t)l * D + k0) * ADA + j);
    f32x4 wv[ADA_KS];
#pragma unroll
    for (int k = 0; k < ADA_KS; ++k) wv[k] = __builtin_nontemporal_load(w + (size_t)k * (ADA / 4));
    if (F.lane < ADA_KS) {
#pragma unroll
        for (int b = 0; b < BATCH; ++b) { const float cv = F_C(F)[b * D + k0 + F.lane]; scr[F.lane * 4 + b] = cv / (1.0f + __expf(-cv)); } }
    LDS_WAIT(); asm volatile("" ::: "memory");
    f32x4 a[BATCH];
#pragma unroll
    for (int b = 0; b < BATCH; ++b) a[b] = (f32x4){0.f, 0.f, 0.f, 0.f};
#pragma unroll
    for (int k = 0; k < ADA_KS; ++k) { const f32x4 cv = *(const LAS f32x4*)(scr + k * 4); a[0] += wv[k] * cv.x; a[1] += wv[k] * cv.y; a[2] += wv[k] * cv.z; a[3] += wv[k] * cv.w; }
    if (ks == 0) { const f32x4 bv = *(const GAS f32x4*)(F_BADA(F) + l * ADA + j);
#pragma unroll
        for (int b = 0; b < BATCH; ++b) a[b] += bv; }
    float* ad = F_ADA(F) + (size_t)(l * BATCH) * ADA + j;
#pragma unroll
    for (int b = 0; b < BATCH; ++b) { int* ai = (int*)(ad + b * ADA); atomicAdd(ai, __float2int_rn(a[b].x * pg8::ADA_FX)); atomicAdd(ai + 1, __float2int_rn(a[b].y * pg8::ADA_FX)); atomicAdd(ai + 2, __float2int_rn(a[b].z * pg8::ADA_FX)); atomicAdd(ai + 3, __float2int_rn(a[b].w * pg8::ADA_FX)); }
    LDS_WAIT(); asm volatile("" ::: "memory");
}
__device__ __forceinline__ void p0a_phase(Frame& F) {
    LAUNDER(F);
    LAS float* scr = (LAS float*)(F.lds + RING_OFF + F.wave * 16384);
    if (F.wave == 0) for (int it = F.vcu; it < 8 * ADA_NKS; it += F.G) p0_ada_item(F, it, scr);
}
__device__ __forceinline__ void p0_tr_dispatch(Frame& F, int r, LAS float* scr) {
    constexpr int I_IN = (D / 64) * (NIN / 32), I_O = (D / 64) * (D / 32), I_1 = (D / 64) * (FF / 32), I_2 = (FF / 64) * (D / 32), I_L = I_IN + I_O + I_1 + I_2;
    const int l = r / I_L; r -= l * I_L;
    bf16* wl = (bf16*)(F_WS(F) + WS_W + (size_t)l * W_LAYER);
    if (r < I_IN) { p0_transpose_item(F_WIN(F) + (size_t)l * D * NIN, D, NIN, wl + WO_IN / 2, 0, scr, r, F.lane); return; } r -= I_IN;
    if (r < I_O) { p0_transpose_item(F_WOUT(F) + (size_t)l * D * D, D, D, wl + WO_OUT / 2, 0, scr, r, F.lane); return; } r -= I_O;
    if (r < I_1) { p0_transpose_item(F_W1(F) + (size_t)l * D * FF, D, FF, wl + WO_1 / 2, 0, scr, r, F.lane); return; } r -= I_1;
    p0_transpose_item(F_W2(F) + (size_t)l * FF * D, FF, D, wl + WO_2 / 2, 0, scr, r, F.lane);
}
constexpr int TR_I_IN = (D / 64) * (NIN / 32), TR_I_O = (D / 64) * (D / 32), TR_I_L = TR_I_IN + TR_I_O + (D / 64) * (FF / 32) + (FF / 64) * (D / 32);
__device__ __forceinline__ void p0b_items(Frame& F) {
    LAUNDER(F);
    LAS float* scr = (LAS float*)(F.lds + RING_OFF + F.wave * 16384);
    const int gw = F.vcu * NWAVES + F.wave, NGW = F.G * NWAVES;
    constexpr int I_ADA = NLAYER * ADA_NCB * ADA_NKS - 8 * ADA_NKS;
    constexpr int NTR = NLAYER * TR_I_L;
    for (int it = gw; it < I_ADA + NTR; it += NGW) {
        if (it < I_ADA) { p0_ada_item(F, it + 8 * ADA_NKS, scr); continue; }
        p0_tr_dispatch(F, it - I_ADA, scr);
    }
}
__device__ __forceinline__ void sw_phase(Frame& F, int part, int nparts) {
    LAUNDER(F);
    const int gw = part * NWAVES + F.wave, NGW = nparts * NWAVES, lane = F.lane;
#pragma unroll 1
    for (int v = 0; v < 3; ++v) {
        const int l = (v == 0) ? 0 : 1, N = (v == 1) ? NIN : FF;
        const bf16* Wt = (const bf16*)(F_WS(F) + WS_W + (size_t)l * W_LAYER) + ((v == 1) ? WO_IN : WO_1) / 2;
        const float* sh = F_ADA(F) + (size_t)l * BATCH * ADA + ((v == 1) ? 0 : 3 * D);
        float* SW = (float*)(F_WS(F) + WS_SW) + (size_t)v * BATCH * 4096;
        f32x4 s[BATCH][4];
#pragma unroll
        for (int b = 0; b < BATCH; ++b)
#pragma unroll
            for (int j = 0; j < 4; ++j) s[b][j] = pg8::ld_ada4(sh + (size_t)b * ADA + (j >> 1) * 512 + lane * 8 + (j & 1) * 4);
        for (int n = gw; n < N; n += NGW) {
            const v4u w0 = *(const GAS v4u*)(Wt + (size_t)n * D + lane * 8), w1 = *(const GAS v4u*)(Wt + (size_t)n * D + 512 + lane * 8);
            float f[16]; unpack8(w0, f); unpack8(w1, f + 8);
            float acc[BATCH];
#pragma unroll
            for (int b = 0; b < BATCH; ++b) { acc[b] = 0.f;
#pragma unroll
                for (int j = 0; j < 4; ++j) acc[b] += (f[4 * j] * s[b][j].x + f[4 * j + 1] * s[b][j].y) + (f[4 * j + 2] * s[b][j].z + f[4 * j + 3] * s[b][j].w); }
#pragma unroll
            for (int b = 0; b < BATCH; ++b) acc[b] = wave_sum(acc[b], lane);
            if (lane < BATCH) SW[(size_t)lane * 4096 + n] = (lane == 0) ? acc[0] : (lane == 1) ? acc[1] : (lane == 2) ? acc[2] : acc[3];
        }
    }
}
__device__ __forceinline__ void xn_phase(Frame& F, const float* xsrc, const float* g, const float* shift, const float* scale, bf16* XN) {
    LAUNDER(F);
    const int gw = F.vcu * NWAVES + F.wave, NGW = F.G * NWAVES;
    for (int rb = gw; rb < M / 8; rb += NGW) {
        const int b = (rb * 8) / SEQ;
        f32x4 gm[4], sh[4];
#pragma unroll
        for (int j = 0; j < 4; ++j) { const int col = 256 * j + 4 * F.lane; const f32x4 gg = *(const f32x4*)(g + col), sc = pg8::ld_ada4(scale + (size_t)b * ADA + col); gm[j] = gg * (sc + 1.0f); sh[j] = pg8::ld_ada4(shift + (size_t)b * ADA + col); }
#pragma unroll 2
        for (int r = 0; r < 8; ++r) { const size_t row = (size_t)rb * 8 + r;
            const GAS f32x4* xr = (const GAS f32x4*)(xsrc + row * D) + F.lane;
            f32x4 v[4]; float s = 0.f;
#pragma unroll
            for (int j = 0; j < 4; ++j) { v[j] = __builtin_nontemporal_load(xr + 64 * j); s += (v[j].x * v[j].x + v[j].y * v[j].y) + (v[j].z * v[j].z + v[j].w * v[j].w); }
            const float rstd = 1.0f / sqrtf(wave_sum(s, F.lane) * (1.0f / D) + EPS);
            GAS unsigned long long* o8 = (GAS unsigned long long*)(XN + row * D) + F.lane;
#pragma unroll
            for (int j = 0; j < 4; ++j) { const f32x4 o = v[j] * rstd * gm[j] + sh[j]; o8[64 * j] = (unsigned long long)pk2(o.x, o.y) | ((unsigned long long)pk2(o.z, o.w) << 32); }
        }
    }
}

__device__ __forceinline__ void ret_scan(Frame& F, const float* KV, bf16* PREV) {
    LAUNDER(F);
    const int gt = F.vcu * (NWAVES * 64) + F.tid, NT = F.G * NWAVES * 64;
    for (int idx = gt; idx < BATCH * 4 * 8192; idx += NT) {
        const int de = idx & 8191, h = (idx >> 13) & 3, b = idx >> 15;
        const float cd = __expf(128.0f * ret_log_gamma(h));
        float s0 = 0.f, s1 = 0.f;
        const size_t base = ((size_t)(b * 32) * 4 + h) * 16384 + 2 * de;
        typedef float f32x2_t __attribute__((ext_vector_type(2)));
        f32x2_t kv[32];
#pragma unroll
        for (int n = 0; n < 32; ++n) kv[n] = __builtin_nontemporal_load((const GAS f32x2_t*)(KV + base + (size_t)n * 65536));
#pragma unroll
        for (int n = 0; n < 32; ++n) {
            const float p0 = cd * s0, p1 = cd * s1;
            *(GAS unsigned*)(PREV + base + (size_t)n * 65536) = pk2(p0, p1);
            s0 = p0 + kv[n].x; s1 = p1 + kv[n].y;
        }
    }
}

typedef float f32x16 __attribute__((ext_vector_type(16)));
typedef short s16x4 __attribute__((ext_vector_type(4)));
typedef short v4i16_t __attribute__((ext_vector_type(4)));
#define MFMA32(a, b, c) __builtin_amdgcn_mfma_f32_32x32x16_bf16((a), (b), (c), 0, 0, 0)
constexpr float LOG2E = 1.4426950408889634f;
__device__ __forceinline__ int crow(int r, int hi) { return (r & 3) + 8 * (r >> 2) + 4 * hi; }
__device__ __forceinline__ s16x4 vtr(const LAS unsigned char* p) { return __builtin_bit_cast(s16x4, __builtin_amdgcn_ds_read_tr16_b64_v4i16((LAS v4i16_t*)p)); }
__device__ __forceinline__ bf16x8 vfrag(const LAS unsigned char* p) { const s16x4 lo = vtr(p), hi = vtr(p + 512); return (bf16x8){lo[0], lo[1], lo[2], lo[3], hi[0], hi[1], hi[2], hi[3]}; }
__device__ __forceinline__ unsigned cvtpk(float lo, float hi) { typedef float f2 __attribute__((ext_vector_type(2))); typedef __bf16 b2 __attribute__((ext_vector_type(2))); f2 v = {lo, hi}; b2 b = __builtin_convertvector(v, b2); return __builtin_bit_cast(unsigned, b); }
__device__ __forceinline__ bf16x8 pack8(const f32x16& x, int s) {
    v4u p; p.x = cvtpk(x[8 * s], x[8 * s + 1]); p.y = cvtpk(x[8 * s + 2], x[8 * s + 3]); p.z = cvtpk(x[8 * s + 4], x[8 * s + 5]); p.w = cvtpk(x[8 * s + 6], x[8 * s + 7]);
    return __builtin_bit_cast(bf16x8, p);
}


__device__ __forceinline__ void mix_publish(int tid, unsigned* c0, unsigned* c1) {
    asm volatile("s_waitcnt vmcnt(0)" ::: "memory"); __syncthreads();
    if (tid == 0) { __builtin_amdgcn_fence(__ATOMIC_RELEASE, "agent"); asm volatile("s_waitcnt vmcnt(0)" ::: "memory");
        __hip_atomic_fetch_add(c0, 1u, __ATOMIC_RELAXED, __HIP_MEMORY_SCOPE_AGENT); if (c1) __hip_atomic_fetch_add(c1, 1u, __ATOMIC_RELAXED, __HIP_MEMORY_SCOPE_AGENT); }
}
__device__ __forceinline__ void mix_publish_xcc(int tid, unsigned* ev  , unsigned nloc, unsigned* c0, unsigned* c1) {
    asm volatile("s_waitcnt vmcnt(0)" ::: "memory"); __syncthreads();
    if (tid == 0) {
        const unsigned old = __hip_atomic_fetch_add(ev, 1u, __ATOMIC_RELAXED, __HIP_MEMORY_SCOPE_AGENT);
        if (old + 1u == nloc) { __builtin_amdgcn_fence(__ATOMIC_RELEASE, "agent"); asm volatile("s_waitcnt vmcnt(0)" ::: "memory");
            __hip_atomic_store(ev + 64, 1u, __ATOMIC_RELAXED, __HIP_MEMORY_SCOPE_AGENT); }
        else { unsigned sp = 0; while (__hip_atomic_load(ev + 64, __ATOMIC_RELAXED, __HIP_MEMORY_SCOPE_AGENT) == 0u) { __builtin_amdgcn_s_sleep(1); if (++sp > (1u << 22)) break; } }
        __hip_atomic_fetch_add(c0, 1u, __ATOMIC_RELAXED, __HIP_MEMORY_SCOPE_AGENT); if (c1) __hip_atomic_fetch_add(c1, 1u, __ATOMIC_RELAXED, __HIP_MEMORY_SCOPE_AGENT); }
}
__device__ __forceinline__ void mix_wait(int wave, unsigned* c0, unsigned w0, unsigned* c1, unsigned w1) {
    if (wave == 0) { unsigned sp = 0;
        asm volatile("buffer_inv sc1" ::: "memory");
        for (;;) { const unsigned a = (unsigned)__builtin_amdgcn_readfirstlane((int)__hip_atomic_load(c0, __ATOMIC_RELAXED, __HIP_MEMORY_SCOPE_AGENT));
            const unsigned b = c1 ? (unsigned)__builtin_amdgcn_readfirstlane((int)__hip_atomic_load(c1, __ATOMIC_RELAXED, __HIP_MEMORY_SCOPE_AGENT)) : w1;
            if (a >= w0 && b >= w1) break; __builtin_amdgcn_s_sleep(2); if (++sp > (1u << 22)) break; }
        asm volatile("s_waitcnt vmcnt(0)" ::: "memory"); }
    __syncthreads();
}
constexpr size_t PANEL_ELEMS = 1u << 20;
__device__ __forceinline__ const bf16* PRW(const bf16* PROJ, size_t row) { return PROJ + (row >> 8) * PANEL_ELEMS + (row & 255) * NIN; }
__device__ __forceinline__ bf16* MXW(bf16* MIX, size_t row) { return MIX + (row >> 8) * PANEL_ELEMS + (row & 255) * D; }
__device__ __forceinline__ void team_sync(int tid, int wave, unsigned* cnt, unsigned want, bool same_xcc, unsigned* guard = nullptr, unsigned gwant = 0u) {
    asm volatile("s_waitcnt vmcnt(0)" ::: "memory"); __syncthreads();
    if (wave == 0) {
        if (tid == 0) { if (!same_xcc) { __builtin_amdgcn_fence(__ATOMIC_RELEASE, "agent"); asm volatile("s_waitcnt vmcnt(0)" ::: "memory"); }
            __hip_atomic_fetch_add(cnt, 1u, __ATOMIC_RELAXED, __HIP_MEMORY_SCOPE_AGENT); }
        unsigned sp = 0;
        asm volatile("buffer_inv sc1" ::: "memory");
        for (;;) { const unsigned a = (unsigned)__builtin_amdgcn_readfirstlane((int)__hip_atomic_load(cnt, __ATOMIC_RELAXED, __HIP_MEMORY_SCOPE_AGENT));
            const unsigned g = guard ? (unsigned)__builtin_amdgcn_readfirstlane((int)__hip_atomic_load(guard, __ATOMIC_RELAXED, __HIP_MEMORY_SCOPE_AGENT)) : gwant;
            if (a >= want && g >= gwant) break; __builtin_amdgcn_s_sleep(1); if (++sp > (1u << 22)) break; }
        asm volatile("s_waitcnt vmcnt(0)" ::: "memory"); }
    __syncthreads();
}
__device__ __forceinline__ void attn_mfma(Frame& F, int layer, const bf16* PROJ, bf16* MIX) {
    LAUNDER(F);
    const int tid = F.tid, lane = F.lane, r32 = lane & 31, hi = lane >> 5, wid = F.wave;
    LAS unsigned char* Kl = F.lds + RING_OFF; LAS unsigned char* Vl = F.lds + RING_OFF + 32768;
    LAS float* wsf = (LAS float*)(F.lds + RING_OFF + 65536) + wid * 64;
    LAS unsigned short* stg = (LAS unsigned short*)(F.lds + RING_OFF + 65536 + 2048) + wid * 2048;
    const float* qg = F_QNG(F) + layer * 64; const float* kg = F_KNG(F) + layer * 64; const float* sk = F_SINKS(F) + layer * 8;
    const int vlane = (4 * hi + ((lane & 15) >> 2)) * 64 + ((lane >> 4) & 1) * 32 + (lane & 3) * 8;
    float qk_bound;
    { float a = fabsf(qg[lane]), b = fabsf(kg[lane]);
#pragma unroll
      for (int o = 1; o < 64; o <<= 1) { a = fmaxf(a, shx(a, o, lane)); b = fmaxf(b, shx(b, o, lane)); }
      qk_bound = 0.125f * LOG2E * 64.0f * 1.01f * a * b; }
    for (int u = F.vcu; u < BATCH * 32 * 2; u += F.G) {
        const int kvh = u & 1, n = (u >> 1) & 31, b = u >> 6;
        __syncthreads();
        { const int r = tid >> 1, hf = tid & 1; const int tok = (n - 1) * 128 + r;
          float kf[32]; float ss = 0.f; v4u vw[4];
          if (tok >= 0) {
              const bf16* kp = PRW(PROJ, (size_t)(b * SEQ + tok)) + C_AK + kvh * 64 + hf * 32;
              const bf16* vp = PRW(PROJ, (size_t)(b * SEQ + tok)) + C_AV + kvh * 64 + hf * 32;
#pragma unroll
              for (int i = 0; i < 4; ++i) { const v4u w = __builtin_nontemporal_load((const GAS v4u*)(kp + 8 * i)); unpack8(w, kf + 8 * i); vw[i] = __builtin_nontemporal_load((const GAS v4u*)(vp + 8 * i)); }
#pragma unroll
              for (int i = 0; i < 32; ++i) ss += kf[i] * kf[i];
          } else {
#pragma unroll
              for (int i = 0; i < 32; ++i) kf[i] = 0.f;
#pragma unroll
              for (int i = 0; i < 4; ++i) vw[i] = (v4u){0u, 0u, 0u, 0u};
          }
          ss += shx(ss, 1, lane);
          const float rstd = 1.0f / sqrtf(ss * (1.0f / 64.0f) + EPS);
#pragma unroll
          for (int i = 0; i < 4; ++i) { v4u o; const float* gp = kg + hf * 32 + 8 * i;
              o.x = pk2(kf[8 * i] * rstd * gp[0], kf[8 * i + 1] * rstd * gp[1]); o.y = pk2(kf[8 * i + 2] * rstd * gp[2], kf[8 * i + 3] * rstd * gp[3]);
              o.z = pk2(kf[8 * i + 4] * rstd * gp[4], kf[8 * i + 5] * rstd * gp[5]); o.w = pk2(kf[8 * i + 6] * rstd * gp[6], kf[8 * i + 7] * rstd * gp[7]);
              *(LAS v4u*)(Kl + (hf * 4 + i) * 4096 + r * 16) = o;
              *(LAS v4u*)(Vl + hf * 16384 + (r >> 4) * 1024 + (r & 15) * 64 + i * 16) = vw[i]; }
        }
        __syncthreads();
        const int h = kvh * 4 + (wid >> 1);
        const float slope2 = ldexpf(LOG2E, -(h + 1)), sink2 = sk[h] * LOG2E;
        const float mref = fmaxf(qk_bound, sink2);
#pragma unroll 1
        for (int qt = 0; qt < 2; ++qt) {
            const int q0 = (wid & 1) * 64 + qt * 32, j0 = q0 >> 5;
            const size_t row = (size_t)b * SEQ + n * 128 + q0 + r32;
            bf16x8 qr[4];
            { float qf[32]; float ss = 0.f; const bf16* qp = PRW(PROJ, row) + C_AQ + h * 64 + 8 * hi;
#pragma unroll
              for (int d0 = 0; d0 < 4; ++d0) { const v4u w = __builtin_nontemporal_load((const GAS v4u*)(qp + 16 * d0)); unpack8(w, qf + 8 * d0); }
#pragma unroll
              for (int i = 0; i < 32; ++i) ss += qf[i] * qf[i];
              ss += shx(ss, 32, lane);
              const float sc = (1.0f / sqrtf(ss * (1.0f / 64.0f) + EPS)) * (0.125f * LOG2E);
#pragma unroll
              for (int d0 = 0; d0 < 4; ++d0) { const float* gp = qg + 16 * d0 + 8 * hi; v4u o;
                  o.x = pk2(qf[8 * d0] * sc * gp[0], qf[8 * d0 + 1] * sc * gp[1]); o.y = pk2(qf[8 * d0 + 2] * sc * gp[2], qf[8 * d0 + 3] * sc * gp[3]);
                  o.z = pk2(qf[8 * d0 + 4] * sc * gp[4], qf[8 * d0 + 5] * sc * gp[5]); o.w = pk2(qf[8 * d0 + 6] * sc * gp[6], qf[8 * d0 + 7] * sc * gp[7]);
                  qr[d0] = __builtin_bit_cast(bf16x8, o); } }
            int r32m = r32, him = hi; asm volatile("" : "+v"(r32m), "+v"(him));
            const float cinit = -slope2 * (float)(128 + r32m - 4 * him) - mref;
            f32x16 cv;
#pragma unroll
            for (int r = 0; r < 16; ++r) cv[r] = cinit;
            f32x16 p[5];
#pragma unroll
            for (int i = 0; i < 5; ++i) { f32x16 acc = cv;
#pragma unroll
                for (int d0 = 0; d0 < 4; ++d0) { const bf16x8 kfr = *(const LAS bf16x8*)(Kl + (2 * d0 + hi) * 4096 + (32 * (j0 + i) + r32) * 16); acc = MFMA32(kfr, qr[d0], acc); }
                p[i] = acc; }
            float l = 0.f;
#pragma unroll
            for (int i = 0; i < 5; ++i) { const bool tile_ok = (n > 0) || (j0 + i >= 4);
#pragma unroll
                for (int r = 0; r < 16; ++r) { const int cr = (r & 3) + 8 * (r >> 2);
                    float e = __builtin_amdgcn_exp2f(__builtin_fmaf(slope2, (float)(32 * i + cr), p[i][r]));
                    bool ok = tile_ok; if (i == 0) ok = ok && (cr + 4 * him > r32m); if (i == 4) ok = ok && (cr + 4 * him <= r32m);
                    e = ok ? e : 0.f; p[i][r] = e; l += e; } }
            l += shx(l, 32, lane); l += __builtin_amdgcn_exp2f(sink2 - mref);
            f32x16 o[2]; o[0] = (f32x16){}; o[1] = (f32x16){};
#pragma unroll
            for (int i = 0; i < 5; ++i)
#pragma unroll
                for (int s = 0; s < 2; ++s) { const bf16x8 pa = pack8(p[i], s);
#pragma unroll
                    for (int d0 = 0; d0 < 2; ++d0) { const bf16x8 vf = vfrag(Vl + d0 * 16384 + (2 * (j0 + i) + s) * 1024 + vlane); o[d0] = MFMA32(pa, vf, o[d0]); } }
            if (hi == 0) wsf[r32] = 1.0f / l;
            float rli[16];
#pragma unroll
            for (int r = 0; r < 16; ++r) rli[r] = wsf[crow(r, hi)];
#pragma unroll
            for (int r = 0; r < 16; ++r) { const int orow = crow(r, hi);
#pragma unroll
                for (int d0 = 0; d0 < 2; ++d0) stg[orow * 64 + d0 * 32 + r32] = (unsigned short)f2bf(o[d0][r] * rli[r]); }
            bf16* Ow = MXW(MIX, (size_t)b * SEQ + n * 128 + q0) + h * 64;
#pragma unroll
            for (int i = 0; i < 4; ++i) { const int orow = i * 8 + (lane >> 3), ch = lane & 7; const v4u v = *(const LAS v4u*)(stg + orow * 64 + ch * 8); *(GAS v4u*)(Ow + (size_t)orow * D + ch * 8) = v; }
        }
    }
    __syncthreads();
}

__device__ __forceinline__ void ret_kv_mfma(Frame& F, const bf16* PROJ, float* KVT, unsigned* cnt_kv  , unsigned* ev, unsigned nloc) {
    LAUNDER(F);
    const int tid = F.tid, lane = F.lane, r32 = lane & 31, hi = lane >> 5, wid = F.wave;
    const int vlane = (4 * hi + ((lane & 15) >> 2)) * 64 + ((lane >> 4) & 1) * 32 + (lane & 3) * 8;
    for (int up = F.vcu; up < 256; up += F.G) {
        __syncthreads();
#pragma unroll 1
        for (int U = 0; U < 2; ++U) { const int u = 2 * up + U, h = u & 3; const size_t row0 = (size_t)(u >> 2) * 128;
            const float lg = ret_log_gamma(h);
            const int r = tid >> 2, part = tid & 3;
            const bf16* kp = PRW(PROJ, row0 + r) + C_RK + h * 128 + part * 32;
            const bf16* vp = PRW(PROJ, row0 + r) + C_RV + h * 128 + part * 32;
            const float dk = __expf(lg * (float)(127 - r)) * 0.08838834764831845f;
            LAS unsigned char* kl = F.lds + RING_OFF + U * 65536 + part * 8192 + (r >> 4) * 1024 + (r & 15) * 64;
#pragma unroll
            for (int i = 0; i < 4; ++i) { const v4u w = *(const GAS v4u*)(kp + 8 * i); float f[8]; unpack8(w, f);
                v4u o; o.x = pk2(f[0] * dk, f[1] * dk); o.y = pk2(f[2] * dk, f[3] * dk); o.z = pk2(f[4] * dk, f[5] * dk); o.w = pk2(f[6] * dk, f[7] * dk);
                *(LAS v4u*)(kl + i * 16) = o;
                *(LAS v4u*)(kl + 32768 + i * 16) = *(const GAS v4u*)(vp + 8 * i); }
        }
        __syncthreads();
#pragma unroll 1
        for (int U = 0; U < 2; ++U) { const int u = 2 * up + U;
            const LAS unsigned char* kl = F.lds + RING_OFF + U * 65536; const LAS unsigned char* vl = kl + 32768;
            const int et = wid >> 1, dt0 = 2 * (wid & 1);
            f32x16 a0 = {}, a1 = {};
#pragma unroll
            for (int ks = 0; ks < 8; ++ks) { const bf16x8 av = vfrag(vl + et * 8192 + ks * 1024 + vlane);
                const bf16x8 b0 = vfrag(kl + dt0 * 8192 + ks * 1024 + vlane), b1 = vfrag(kl + (dt0 + 1) * 8192 + ks * 1024 + vlane);
                a0 = MFMA32(av, b0, a0); a1 = MFMA32(av, b1, a1); }
            float* op = KVT + (size_t)u * 16384 + (size_t)(32 * et) * 128 + 32 * dt0 + r32;
#pragma unroll
            for (int r = 0; r < 16; ++r) { const int e = crow(r, hi); op[e * 128] = a0[r]; op[e * 128 + 32] = a1[r]; }
        }
        { const int u0 = 2 * up, bh0 = ((u0 >> 7) << 2) | (u0 & 3);
          mix_publish_xcc(tid, ev, nloc, cnt_kv + 64 * bh0, cnt_kv + 64 * (bh0 + 1)); }
    }
    __syncthreads();
}
__device__ __forceinline__ void ret_out_mfma(Frame& F, int layer, const bf16* PROJ, const bf16* PREVT, bf16* MIX, unsigned* sc0, unsigned* sc1  ) {
    LAUNDER(F);
    const int tid = F.tid, lane = F.lane, r32 = lane & 31, hi = lane >> 5, wid = F.wave;
    const int vlane = (4 * hi + ((lane & 15) >> 2)) * 64 + ((lane >> 4) & 1) * 32 + (lane & 3) * 8;
    const float* gain = F_RNG(F) + layer * 512;
    for (int up = F.vcu; up < 256; up += F.G) {
        __syncthreads();
        const int U = wid >> 2, it = U ? 3 - (wid & 3) : (wid & 3);
        const int u = 2 * up + U, h = u & 3; const size_t row = (size_t)(u >> 2) * 128 + 32 * it + r32;
        bf16x8 qf[8];
        { const bf16* qp = PRW(PROJ, row) + C_RQ + h * 128 + 8 * hi;
#pragma unroll
          for (int ds = 0; ds < 8; ++ds) qf[ds] = __builtin_nontemporal_load((const GAS bf16x8*)(qp + 16 * ds)); }
#pragma unroll 1
        for (int Us = 0; Us < 2; ++Us) { const int us = 2 * up + Us, hs = us & 3; const size_t row0 = (size_t)(us >> 2) * 128;
            const float lg = ret_log_gamma(hs);
            const int r = tid >> 2, part = tid & 3;
            const bf16* kp = PRW(PROJ, row0 + r) + C_RK + hs * 128 + part * 32;
            const bf16* vp = PRW(PROJ, row0 + r) + C_RV + hs * 128 + part * 32;
            const float dk = __expf(lg * (float)(127 - r)) * 0.08838834764831845f;
            LAS unsigned char* kl = F.lds + RING_OFF + Us * 65536 + (part * 4) * 2048 + r * 16;
            LAS unsigned char* vl = F.lds + RING_OFF + Us * 65536 + 32768 + part * 8192 + (r >> 4) * 1024 + (r & 15) * 64;
#pragma unroll
            for (int i = 0; i < 4; ++i) { const v4u w = __builtin_nontemporal_load((const GAS v4u*)(kp + 8 * i)); float f[8]; unpack8(w, f);
                v4u o; o.x = pk2(f[0] * dk, f[1] * dk); o.y = pk2(f[2] * dk, f[3] * dk); o.z = pk2(f[4] * dk, f[5] * dk); o.w = pk2(f[6] * dk, f[7] * dk);
                *(LAS v4u*)(kl + i * 2048) = o;
                *(LAS v4u*)(vl + i * 16) = __builtin_nontemporal_load((const GAS v4u*)(vp + 8 * i)); }
        }
        __syncthreads();
        const LAS unsigned char* kl = F.lds + RING_OFF + U * 65536; const LAS unsigned char* vl = kl + 32768;
        f32x16 acc[4];
#pragma unroll
        for (int et = 0; et < 4; ++et) acc[et] = (f32x16){};
#pragma unroll 1
        for (int jt = 0; jt <= it; ++jt) {
            f32x16 S = {};
#pragma unroll
            for (int ds = 0; ds < 8; ++ds) { const bf16x8 kfr = *(const LAS bf16x8*)(kl + (2 * ds + hi) * 2048 + (32 * jt + r32) * 16); S = MFMA32(kfr, qf[ds], S); }
            if (jt == it) {
#pragma unroll
                for (int r = 0; r < 16; ++r) S[r] = (crow(r, hi) <= r32) ? S[r] : 0.f; }
            const bf16x8 pb0 = pack8(S, 0), pb1 = pack8(S, 1);
#pragma unroll
            for (int et = 0; et < 4; ++et) { const bf16x8 v0 = vfrag(vl + et * 8192 + (2 * jt) * 1024 + vlane), v1 = vfrag(vl + et * 8192 + (2 * jt + 1) * 1024 + vlane);
                acc[et] = MFMA32(v0, pb0, acc[et]); acc[et] = MFMA32(v1, pb1, acc[et]); }
        }
        mix_wait(wid, sc0, 16u, sc1, 16u);
        { const bf16* pp = PREVT + (size_t)u * 16384 + (size_t)r32 * 128 + 8 * hi;
#pragma unroll
          for (int ds = 0; ds < 8; ++ds)
#pragma unroll
              for (int et = 0; et < 4; ++et) { const bf16x8 pa = *(const GAS bf16x8*)(pp + (size_t)(32 * et) * 128 + 16 * ds); acc[et] = MFMA32(pa, qf[ds], acc[et]); } }
        const float dq = __expf(ret_log_gamma(h) * (float)(32 * it + r32 - 127));
        float s1 = 0.f;
#pragma unroll
        for (int et = 0; et < 4; ++et)
#pragma unroll
            for (int r = 0; r < 16; ++r) { acc[et][r] *= dq; s1 += acc[et][r]; }
        s1 += shx(s1, 32, lane);
        const float mu = s1 * (1.0f / 128.0f);
        float s2 = 0.f;
#pragma unroll
        for (int et = 0; et < 4; ++et)
#pragma unroll
            for (int r = 0; r < 16; ++r) { acc[et][r] -= mu; s2 += acc[et][r] * acc[et][r]; }
        s2 += shx(s2, 32, lane);
        const float rstd = 1.0f / sqrtf(s2 * (1.0f / 128.0f) + EPS);
        { LAS unsigned char* stg = F.lds + RSTG_OFF + wid * 2560;
          const size_t rowb = (size_t)(u >> 2) * 128 + 32 * it;
          const int orow = lane >> 2, oc = lane & 3;
          v4u gw[4][2];
#pragma unroll
          for (int et = 0; et < 4; ++et)
#pragma unroll
              for (int j = 0; j < 2; ++j) gw[et][j] = __builtin_nontemporal_load((const GAS v4u*)(PRW(PROJ, rowb + 16 * j + orow) + C_RG + h * 128 + 32 * et + 8 * oc));
#pragma unroll
          for (int et = 0; et < 4; ++et) {
#pragma unroll
              for (int rg = 0; rg < 4; ++rg) { typedef unsigned u32x2 __attribute__((ext_vector_type(2))); u32x2 w;
                  w.x = cvtpk(acc[et][4 * rg] * rstd, acc[et][4 * rg + 1] * rstd); w.y = cvtpk(acc[et][4 * rg + 2] * rstd, acc[et][4 * rg + 3] * rstd);
                  *(LAS u32x2*)(stg + r32 * 80 + (8 * rg + 4 * hi) * 2) = w; }
#pragma unroll
              for (int j = 0; j < 2; ++j) { const v4u yw = *(const LAS v4u*)(stg + (16 * j + orow) * 80 + oc * 16);
                  float y[8], g[8]; unpack8(yw, y); unpack8(gw[et][j], g);
                  const float* gn = gain + h * 128 + 32 * et + 8 * oc; const f32x4 g0 = *(const f32x4*)gn, g1 = *(const f32x4*)(gn + 4);
                  const float gv[8] = {g0.x, g0.y, g0.z, g0.w, g1.x, g1.y, g1.z, g1.w};
                  float o[8];
#pragma unroll
                  for (int e = 0; e < 8; ++e) o[e] = (g[e] * __builtin_amdgcn_rcpf(1.0f + __builtin_amdgcn_exp2f(-LOG2E * g[e]))) * y[e] * gv[e];
                  v4u ow; ow.x = pk2(o[0], o[1]); ow.y = pk2(o[2], o[3]); ow.z = pk2(o[4], o[5]); ow.w = pk2(o[6], o[7]);
                  *(GAS v4u*)(MXW(MIX, rowb + 16 * j + orow) + 512 + h * 128 + 32 * et + 8 * oc) = ow; }
          }
        }
    }
    __syncthreads();
}
#ifndef CHAOS
#define CHAOS 0
#endif
#define CHAOS_DELAY(which, cond) do { if (CHAOS == (which) && (cond)) { const unsigned long long t0_ = __builtin_amdgcn_s_memrealtime(); while (__builtin_amdgcn_s_memrealtime() - t0_ < 10000ull) __builtin_amdgcn_s_sleep(32); } } while (0)
__global__ void __launch_bounds__(NWAVES * 64, 2) fwd(Args args_unused_directly) {
    extern __shared__ __attribute__((aligned(16))) unsigned char lds[];
    Frame F;
    F.lds = (LAS unsigned char*)lds;
    F.wave0 = __builtin_amdgcn_readfirstlane((int)threadIdx.x >> 6);
    F.G0 = gridDim.x; { const int bx = blockIdx.x; F.vcu0 = (F.G0 % 8 == 0) ? (bx % 8) * (F.G0 / 8) + bx / 8 : bx; }
    LAUNDER(F);
    volatile LAS unsigned* MISC = (volatile LAS unsigned*)(F.lds + MISC_OFF);
    for (int u = F.tid; u < (LDS_BYTES - LDSCTL_OFF) / 4; u += NWAVES * 64) ((LAS unsigned*)(F.lds + LDSCTL_OFF))[u] = 0u;
    __syncthreads();
    XcdBarrier bar = xcd_barrier_post((unsigned*)(F_WS(F) + WS_CTL) + CW_BAR, MISC + 8, F.tid);
    if (F.tid == 0) __hip_atomic_store((unsigned*)(F_WS(F) + WS_CTL) + CW_XCC + F.vcu0, (unsigned)(__builtin_amdgcn_s_getreg((3 << 11) | 20) & 0xFu) + 1u, __ATOMIC_RELAXED, __HIP_MEMORY_SCOPE_AGENT);
#define GRID_BAR() do { LAUNDER(F); bar.bar = (unsigned*)(F_WS(F) + WS_CTL) + CW_BAR; { unsigned x_; asm volatile("s_getreg_b32 %0, hwreg(HW_REG_XCC_ID, 0, 4)" : "=s"(x_)); bar.x = x_ & 0xFu; } xcd_barrier(bar, F.tid); } while (0)
#define WSP(off) (get_args()->ws + (off))
#define TEAM_T (F.vcu >> 2)
#define TEAM_Q (F.vcu & 3)
#define TEAM_CNT(l_, t_) ((unsigned*)(F_WS(F) + WS_CTL) + CW_TEAM + ((l_) * 64 + (t_)) * 64)
#define TEAM_XCC(t_) ({ const unsigned* xt_ = (const unsigned*)(F_WS(F) + WS_CTL) + CW_XCC + 4 * (t_); const unsigned a_ = __hip_atomic_load(xt_, __ATOMIC_RELAXED, __HIP_MEMORY_SCOPE_AGENT), b_ = __hip_atomic_load(xt_ + 1, __ATOMIC_RELAXED, __HIP_MEMORY_SCOPE_AGENT), \
        c_ = __hip_atomic_load(xt_ + 2, __ATOMIC_RELAXED, __HIP_MEMORY_SCOPE_AGENT), d_ = __hip_atomic_load(xt_ + 3, __ATOMIC_RELAXED, __HIP_MEMORY_SCOPE_AGENT); (unsigned)__builtin_amdgcn_readfirstlane((int)((a_ == b_ && a_ == c_ && a_ == d_) ? a_ : 0u)); })
#define TEAM_SAME() (TEAM_XCC(TEAM_T) != 0u)
#define TEAM_SAME_NEXT() ({ const unsigned me_ = TEAM_XCC(TEAM_T); const unsigned nx_ = ((TEAM_T & 15) != 15) ? TEAM_XCC(TEAM_T + 1) : me_; (bool)(me_ != 0u && me_ == nx_); })
#define TEAM_SYNC(l_, stage_) do { LAUNDER(F); team_sync(F.tid, F.wave, TEAM_CNT(l_, TEAM_T), 4u * (unsigned)(stage_), TEAM_SAME()); } while (0)
#define TEAM_SYNC_X(l_, stage_) do { LAUNDER(F); team_sync(F.tid, F.wave, TEAM_CNT(l_, TEAM_T), 4u * (unsigned)(stage_), TEAM_SAME_NEXT()); } while (0)
#define TEAM_SYNC_GUARD(l_, stage_, gt_, gstage_) do { LAUNDER(F); team_sync(F.tid, F.wave, TEAM_CNT(l_, TEAM_T), 4u * (unsigned)(stage_), TEAM_SAME(), TEAM_CNT(l_, gt_), 4u * (unsigned)(gstage_)); } while (0)
#define INPROJ(l_) do { LAUNDER(F); const bf16* wl = (const bf16*)(F_WS(F) + WS_W + (size_t)(l_) * W_LAYER); \
        pg8::Gemm g{(const bf16*)(F_WS(F) + WS_XN), wl + WO_IN / 2, M, NIN, D, 256u * D * 2u}; pg8::TeamOrder S{TEAM_T, 3 * TEAM_Q, (TEAM_Q == 3) ? 2 : 3}; \
        if ((l_) == 0) { pg8::EpiBf16<0, 0> E{(bf16*)(F_WS(F) + WS_PROJ), NIN, nullptr, nullptr, 0, SEQ, 0.f, 0.f, (unsigned)PANEL_ELEMS}; \
            pg8::gemm_phase<pg8::EpiBf16<0, 0>, pg8::TeamOrder, PG8_ALIGN, PG8_SP2>(F.lds + RING_OFF, g, S, E, F.wave); \
            if (TEAM_Q == 3) { sw_phase(F, TEAM_T, 64); LAUNDER(F); mix_publish(F.tid, (unsigned*)(F_WS(F) + WS_CTL) + CW_SWCNT, nullptr); } } \
        else { pg8::EpiBf16<0, 1> E{(bf16*)(F_WS(F) + WS_PROJ), NIN, (const float*)(F_WS(F) + WS_SSQ) + 1 * M, (const float*)(F_WS(F) + WS_SW) + 1 * BATCH * 4096, 4096, SEQ, 1.0f / D, EPS, (unsigned)PANEL_ELEMS}; \
            pg8::gemm_phase<pg8::EpiBf16<0, 1>, pg8::TeamOrder, PG8_ALIGN, PG8_SP2>(F.lds + RING_OFF, g, S, E, F.wave); } } while (0)

    p0a_phase(F); p0b_items(F); GRID_BAR();
    CHAOS_DELAY(1, (F.vcu0 >> 2) & 1);
    { LAUNDER(F); const float* ada_0 = F_ADA(F);
      xn_phase(F, F_X(F), F_N1G(F), ada_0 + 0 * D, ada_0 + 1 * D, (bf16*)(F_WS(F) + WS_XN));
      TEAM_SYNC(NLAYER, 1); INPROJ(0); TEAM_SYNC_X(NLAYER, 2); }
#pragma unroll 1
    for (int l = 0; l < NLAYER; ++l) {
        {
            unsigned* cnt_kv = (unsigned*)(get_args()->ws + WS_CTL) + CW_MIX + (l * 2 + 0) * 1024;
#define XEV(l_, e_) ((unsigned*)(get_args()->ws + WS_CTL) + CW_XEV + ((((l_) * 2 + (e_)) * 16 + (int)((unsigned)__builtin_amdgcn_s_getreg((3 << 11) | 20) & 0xFu)) * 128))
            ret_kv_mfma(F, (const bf16*)WSP(WS_PROJ), (float*)WSP(WS_KV), cnt_kv, XEV(l, 0), MISC[8]);
            { LAUNDER(F);
              if (TEAM_Q < 2 && (TEAM_T & 15) != 0) mix_wait(F.wave, TEAM_CNT((l == 0) ? NLAYER : l - 1, TEAM_T - 1), (l == 0) ? 8u : 20u, nullptr, 0u); }
            CHAOS_DELAY(2, ((F.vcu0 >> 2) & 1) == 0); CHAOS_DELAY(5, (F.vcu0 & 3) == 2);
            attn_mfma(F, l, (const bf16*)WSP(WS_PROJ), (bf16*)WSP(WS_MIX));
            { LAUNDER(F); cnt_kv = (unsigned*)(F_WS(F) + WS_CTL) + CW_MIX + (l * 2 + 0) * 1024;
              const int bh = F.vcu >> 4; mix_wait(F.wave, cnt_kv + 64 * bh, 32u, nullptr, 0u);
              ret_scan(F, (const float*)WSP(WS_KV), (bf16*)WSP(WS_PREV));
              LAUNDER(F); mix_publish_xcc(F.tid, XEV(l, 1), MISC[8], (unsigned*)(F_WS(F) + WS_CTL) + CW_MIX + (l * 2 + 1) * 1024 + 64 * (F.vcu >> 4), nullptr); }
            { const int u0 = 2 * F.vcu0, bh0 = ((u0 >> 7) << 2) | (u0 & 3); unsigned* cs = (unsigned*)(get_args()->ws + WS_CTL) + CW_MIX + (l * 2 + 1) * 1024;
              ret_out_mfma(F, l, (const bf16*)WSP(WS_PROJ), (const bf16*)WSP(WS_PREV), (bf16*)WSP(WS_MIX), cs + 64 * bh0, cs + 64 * (bh0 + 1)); }
            TEAM_SYNC(l, 1);
        }
        {
            { LAUNDER(F); const bf16* wl = (const bf16*)(F_WS(F) + WS_W + (size_t)l * W_LAYER); const float* ada_l = F_ADA(F) + (size_t)l * BATCH * ADA;
              pg8::Gemm g{(const bf16*)(F_WS(F) + WS_MIX), wl + WO_OUT / 2, M, D, D, (unsigned)(PANEL_ELEMS * 2)}; pg8::TeamOrder S{TEAM_T, TEAM_Q, 1};
              if (l == 0) { pg8::EpiResGate<1, 0, 1> E{F_X(F), F_OUT(F), D, ada_l + 2 * D, ADA, SEQ, (bf16*)(F_WS(F) + WS_XN), F_N2G(F) + l * D, ada_l + 4 * D, (float*)(F_WS(F) + WS_SSQ) + (size_t)(2 * l) * M, 256u * D, 524288u};
                  pg8::gemm_phase<pg8::EpiResGate<1, 0, 1>, pg8::TeamOrder, PG8_ALIGN, PG8_SP2>(F.lds + RING_OFF, g, S, E, F.wave); }
              else { pg8::EpiResGate<1, 1, 1> E{F_OUT(F), F_WS(F) + WS_KV, D, ada_l + 2 * D, ADA, SEQ, (bf16*)(F_WS(F) + WS_XN), F_N2G(F) + l * D, ada_l + 4 * D, (float*)(F_WS(F) + WS_SSQ) + (size_t)(2 * l) * M, 524288u, 256u * D};
                  pg8::gemm_phase<pg8::EpiResGate<1, 1, 1>, pg8::TeamOrder, PG8_ALIGN, PG8_SP2>(F.lds + RING_OFF, g, S, E, F.wave); } }
            CHAOS_DELAY(3, (F.vcu0 >> 2) & 1);
            if ((TEAM_T & 15) != 15) TEAM_SYNC_GUARD(l, 2, TEAM_T + 1, 1); else TEAM_SYNC(l, 2);
            CHAOS_DELAY(4, ((F.vcu0 >> 2) % 3) == 0);
            if (l == 0) { LAUNDER(F); mix_wait(F.wave, (unsigned*)(F_WS(F) + WS_CTL) + CW_SWCNT, 64u, nullptr, 0u); }
            { LAUNDER(F); const bf16* wl = (const bf16*)(F_WS(F) + WS_W + (size_t)l * W_LAYER);
              pg8::Gemm g{(const bf16*)(F_WS(F) + WS_XN), wl + WO_1 / 2, M, FF, D, 256u * D * 2u}; pg8::TeamOrder S{TEAM_T, 4 * TEAM_Q, 4};
              pg8::EpiBf16<1, 1> E{(bf16*)(F_WS(F) + WS_H), FF, (const float*)(F_WS(F) + WS_SSQ) + (size_t)(2 * l) * M, (const float*)(F_WS(F) + WS_SW) + (size_t)(2 * l) * BATCH * 4096, 4096, SEQ, 1.0f / D, EPS, 256u * FF};
              pg8::gemm_phase<pg8::EpiBf16<1, 1>, pg8::TeamOrder, PG8_ALIGN, PG8_SP2>(F.lds + RING_OFF, g, S, E, F.wave); }
            TEAM_SYNC(l, 3);
            { LAUNDER(F); const bf16* wl = (const bf16*)(F_WS(F) + WS_W + (size_t)l * W_LAYER); const float* ada_l = F_ADA(F) + (size_t)l * BATCH * ADA;
              pg8::Gemm g{(const bf16*)(F_WS(F) + WS_H), wl + WO_2 / 2, M, D, FF, 256u * FF * 2u}; pg8::TeamOrder S{TEAM_T, TEAM_Q, 1};
              if (l + 1 < NLAYER) { const float* ada_n = ada_l + (size_t)BATCH * ADA;
                  pg8::EpiResGate<1, 1, 1> E{F_OUT(F), F_OUT(F), D, ada_l + 5 * D, ADA, SEQ, (bf16*)(F_WS(F) + WS_XN), F_N1G(F) + (l + 1) * D, ada_n + 1 * D, (float*)(F_WS(F) + WS_SSQ) + (size_t)(2 * l + 1) * M, 524288u, 524288u};
                  pg8::gemm_phase<pg8::EpiResGate<1, 1, 1>, pg8::TeamOrder, PG8_ALIGN, PG8_SP2>(F.lds + RING_OFF, g, S, E, F.wave); }
              else { pg8::EpiResGate<0, 1, 0> E{F_WS(F) + WS_KV, F_OUT(F), D, ada_l + 5 * D, ADA, SEQ, nullptr, nullptr, nullptr, nullptr, 256u * D, 256u * D};
                  pg8::gemm_phase<pg8::EpiResGate<0, 1, 0>, pg8::TeamOrder, PG8_ALIGN, PG8_SP2>(F.lds + RING_OFF, g, S, E, F.wave); } }
            CHAOS_DELAY(6, ((F.vcu0 >> 2) & 3) == 1);
            if (l + 1 < NLAYER) { TEAM_SYNC(l, 4); INPROJ(l + 1); TEAM_SYNC_X(l, 5); }
        }
    }
}

extern "C" void kernel_launch(void* const* d_in, const int* in_sizes, int n_in, void* d_out, int out_size, void* d_ws, size_t ws_size, hipStream_t stream) {
    static int grid = 0;
    if (grid == 0) {
        if (n_in != 14 || in_sizes[0] != M * D || out_size != M * D || ws_size < WS_END) { fprintf(stderr, "kernel_launch: unexpected shapes (n_in %d, in0 %d, out %d, ws %zu); nothing launched\n", n_in, n_in > 0 ? in_sizes[0] : -1, out_size, ws_size); grid = -1; return; }
        int dev = 0, cus = 0, per_cu = 0;
        if (hipGetDevice(&dev) != hipSuccess || hipDeviceGetAttribute(&cus, hipDeviceAttributeMultiprocessorCount, dev) != hipSuccess) { grid = -1; return; }
        if (hipFuncSetAttribute((const void*)fwd, hipFuncAttributeMaxDynamicSharedMemorySize, LDS_BYTES) != hipSuccess) { fprintf(stderr, "kernel_launch: hipFuncSetAttribute failed\n"); grid = -1; return; }
        if (hipOccupancyMaxActiveBlocksPerMultiprocessor(&per_cu, (const void*)fwd, NWAVES * 64, LDS_BYTES) != hipSuccess || per_cu < 1) { fprintf(stderr, "kernel_launch: occupancy query reports %d blocks per CU\n", per_cu); }
        (void)hipGetLastError();
        grid = cus;
        if (cus != 256) { fprintf(stderr, "kernel_launch: built for a 256-CU device (work maps are static per workgroup); this device reports %d CUs; nothing launched\n", cus); grid = -1; return; }
    }
    if (grid < 0) return;
    if (hipMemsetAsync((char*)d_ws + WS_CTL, 0, CTL_ZERO_BYTES, stream) != hipSuccess) { fprintf(stderr, "kernel_launch: hipMemsetAsync failed\n"); return; }
    Args a{};
    for (int i = 0; i < 14; ++i) a.in[i] = (const float*)d_in[i];
    a.out = (float*)d_out; a.ws = (unsigned char*)d_ws;
    hipLaunchKernelGGL(fwd, dim3(grid), dim3(NWAVES * 64), LDS_BYTES, stream, a);
    const hipError_t le = hipPeekAtLastError();
    if (le != hipSuccess) fprintf(stderr, "kernel_launch: launch failed: %s\n", hipGetErrorName(le));
}
```

```cpp
#include <hip/hip_runtime.h>
#include <cstdio>
#include <cstdint>
namespace pg8 {
#define PG8_LAS __attribute__((address_space(3)))
typedef unsigned short bf16_t;
typedef short bf16x8 __attribute__((ext_vector_type(8)));
typedef float f32x4 __attribute__((ext_vector_type(4)));
typedef unsigned u32x4 __attribute__((ext_vector_type(4)));
constexpr int BM = 256, BK = 64, HALF = 128, HTB = HALF * BK * 2  , STAGE_BYTES = 8 * HTB, NXCD = 8, WGM = 8;

__host__ __device__ __forceinline__ int lds_byte(int r, int c) { const int st = (r >> 4) * 2 + (c >> 5), rr = r & 15, cc = c & 31, ob = rr * 64 + cc * 2; return st * 1024 + (ob ^ (((ob >> 9) & 1) << 5)); }
__host__ __device__ __forceinline__ void stage_rc(int b, int& R, int& C) { const int st = b / 1024, sb = b % 1024, swz = sb ^ (((sb >> 9) & 1) << 5); R = (st >> 1) * 16 + swz / 64; C = (st & 1) * 32 + (swz % 64) / 2; }
__host__ __device__ __forceinline__ int perm32(int rho) { const int n = rho >> 4, i = rho & 15; return 8 * (i >> 2) + 4 * n + (i & 3); }

struct Unit { int pm, pn; };
struct Gemm { const bf16_t* A; const bf16_t* Bt; int M, N, K; unsigned a_panel_bytes; };

struct StaticOrder {
    int nM, nN, nwg, G, c;
    __host__ __device__ void init(int M, int N, int G_, int c_) { nM = M / BM; nN = N / BM; nwg = nM * nN; G = G_; c = c_; }
    __host__ __device__ bool next(int i, Unit& u) const {
        const long L = (long)i * G + c; if (L >= nwg) return false;
        int wgid = (int)L; { const int q = nwg / NXCD, r = nwg % NXCD, xcd = wgid % NXCD, off = wgid / NXCD; wgid = (xcd < r ? xcd * (q + 1) : r * (q + 1) + (xcd - r) * q) + off; }
        const int nig = WGM * nN, gid = wgid / nig, fm = gid * WGM, gsz = (nM - fm) < WGM ? (nM - fm) : WGM;
        u.pm = fm + ((wgid % nig) % gsz); u.pn = (wgid % nig) / gsz; return true;
    }
    __device__ __forceinline__ void a_ready(const Unit&) const {}
    __device__ __forceinline__ void done(const Unit&) const {}
};


struct TeamOrder {
    int pm, pn0, cnt;
    __device__ __forceinline__ bool next(int i, Unit& u) const { if (i >= cnt) return false; u.pm = pm; u.pn = pn0 + i; return true; }
    __device__ __forceinline__ void a_ready(const Unit&) const {}
    __device__ __forceinline__ void done(const Unit&) const {}
};
__device__ __forceinline__ unsigned cvt_pk_bf16(float lo, float hi) { unsigned r; asm volatile("v_cvt_pk_bf16_f32 %0, %1, %2" : "=v"(r) : "v"(lo), "v"(hi)); return r; }

constexpr float ADA_FX = 16777216.0f, ADA_IFX = 1.0f / 16777216.0f, SSQ_FX = 4096.0f, SSQ_IFX = 1.0f / 4096.0f;
typedef int i32x4 __attribute__((ext_vector_type(4)));
__device__ __forceinline__ f32x4 ld_ada4(const float* p) { const i32x4 v = *(const i32x4*)p; return (f32x4){(float)v.x, (float)v.y, (float)v.z, (float)v.w} * ADA_IFX; }
typedef unsigned u32x2_t __attribute__((ext_vector_type(2)));
#ifndef PG8_ST_AUX
#define PG8_ST_AUX 0
#endif
#ifndef PG8_RES_AUX
#define PG8_RES_AUX 0
#endif
#define PG8_RSRC(p) __builtin_amdgcn_make_buffer_rsrc((void*)(p), 0, 0x7ffffff0, 0x00020000)
__device__ __forceinline__ void st16_wt(__amdgpu_buffer_rsrc_t r, unsigned byte_off, u32x4 v) { __builtin_amdgcn_raw_buffer_store_b128(v, r, byte_off, 0, PG8_ST_AUX); }
__device__ __forceinline__ void st8_wt(__amdgpu_buffer_rsrc_t r, unsigned byte_off, u32x2_t v) { __builtin_amdgcn_raw_buffer_store_b64(v, r, byte_off, 0, PG8_ST_AUX); }
template <int ACT  , int NORM> struct EpiBf16 {
    static constexpr bool PERM = true, AFTER_DRAIN = false;
    bf16_t* O; int ldc; const float* ssq; const float* sw; int sw_bstride; int rows_per_batch; float inv_n, eps; unsigned o_panel_elems;
    __device__ __forceinline__ void operator()(const f32x4 (&acc)[2][2][4][2], const Unit& u, int wr, int wc, int fr_in, int fq_in) const {
        int fr = fr_in, fq = fq_in; asm volatile("" : "+v"(fr), "+v"(fq));
        const int row0 = u.pm * BM + wr * 64 + fr; const int col0 = u.pn * BM + wc * 32 + 8 * fq;
        const __amdgpu_buffer_rsrc_t rO = PG8_RSRC(O);
        f32x4 sv[2][2];
        if (NORM) { const float* sp = sw + (size_t)((u.pm * BM) / rows_per_batch) * sw_bstride + col0;
#pragma unroll
            for (int bj = 0; bj < 2; ++bj) { sv[bj][0] = *(const f32x4*)(sp + bj * HALF); sv[bj][1] = *(const f32x4*)(sp + bj * HALF + 4); } }
#pragma unroll
        for (int ai = 0; ai < 2; ++ai)
#pragma unroll
            for (int m = 0; m < 4; ++m) { const int row = row0 + ai * HALF + m * 16; const unsigned rowb = ((unsigned)u.pm * o_panel_elems + (unsigned)(row - u.pm * BM) * (unsigned)ldc + (unsigned)col0) * 2u;
                float rs = 1.f; if (NORM) rs = __builtin_amdgcn_rsqf((float)((const int*)ssq)[row] * (inv_n * SSQ_IFX) + eps);
#pragma unroll
                for (int bj = 0; bj < 2; ++bj) { f32x4 v0 = acc[ai][bj][m][0], v1 = acc[ai][bj][m][1];
                    if (NORM) { v0 = v0 * rs + sv[bj][0]; v1 = v1 * rs + sv[bj][1]; }
                    if (ACT == 1) {
#pragma unroll
                        for (int e = 0; e < 4; ++e) { const float a = fmaxf(v0[e], 0.f), b = fmaxf(v1[e], 0.f); v0[e] = a * a; v1[e] = b * b; } }
                    u32x4 w; w.x = cvt_pk_bf16(v0[0], v0[1]); w.y = cvt_pk_bf16(v0[2], v0[3]); w.z = cvt_pk_bf16(v1[0], v1[1]); w.w = cvt_pk_bf16(v1[2], v1[3]);
                    st16_wt(rO, rowb + bj * HALF * 2, w); } }
    }
};
template <int XG, int BIN, int BOUT> struct EpiResGate {
    static constexpr bool PERM = true, AFTER_DRAIN = false;
    const void* base; void* out; int ldc; const float* gate; int gate_bstride; int rows_per_batch;
    bf16_t* xg; const float* ng; const float* scale; float* ssq; unsigned base_panel, out_panel;
    __device__ __forceinline__ void operator()(const f32x4 (&acc)[2][2][4][2], const Unit& u, int wr, int wc, int fr_in, int fq_in) const {
        int fr = fr_in, fq = fq_in; asm volatile("" : "+v"(fr), "+v"(fq));
        const int row0 = u.pm * BM + wr * 64 + fr, col0 = u.pn * BM + wc * 32 + 8 * fq, lane = fr + 16 * fq;
        const int b = (u.pm * BM) / rows_per_batch;
        const __amdgpu_buffer_rsrc_t rOut = PG8_RSRC(out), rXg = PG8_RSRC(xg);
        const float* gp = gate + (size_t)b * gate_bstride + col0;
        f32x4 gv[2][2], gm[2][2];
#pragma unroll
        for (int bj = 0; bj < 2; ++bj)
#pragma unroll
            for (int n = 0; n < 2; ++n) { gv[bj][n] = ld_ada4(gp + bj * HALF + n * 4);
                if (XG) gm[bj][n] = *(const f32x4*)(ng + col0 + bj * HALF + n * 4) * (ld_ada4(scale + (size_t)b * gate_bstride + col0 + bj * HALF + n * 4) + 1.0f); }
#pragma unroll
        for (int ai = 0; ai < 2; ++ai)
#pragma unroll
            for (int m = 0; m < 4; ++m) { const int row = row0 + ai * HALF + m * 16; const size_t off = (size_t)row * ldc + col0; float ss = 0.f;
                const size_t offb = (size_t)u.pm * base_panel + (size_t)(row - u.pm * BM) * ldc + col0, offo = (size_t)u.pm * out_panel + (size_t)(row - u.pm * BM) * ldc + col0;
#pragma unroll
                for (int bj = 0; bj < 2; ++bj) { f32x4 b0, b1;
                    if (BIN) { const u32x4 w = __builtin_nontemporal_load((const u32x4*)((const bf16_t*)base + offb + bj * HALF));
                        b0 = (f32x4){__uint_as_float(w.x << 16), __uint_as_float(w.x & 0xffff0000u), __uint_as_float(w.y << 16), __uint_as_float(w.y & 0xffff0000u)};
                        b1 = (f32x4){__uint_as_float(w.z << 16), __uint_as_float(w.z & 0xffff0000u), __uint_as_float(w.w << 16), __uint_as_float(w.w & 0xffff0000u)}; }
                    else { b0 = __builtin_nontemporal_load((const f32x4*)((const float*)base + offb + bj * HALF)); b1 = __builtin_nontemporal_load((const f32x4*)((const float*)base + offb + bj * HALF + 4)); }
                    const f32x4 o0 = b0 + gv[bj][0] * acc[ai][bj][m][0], o1 = b1 + gv[bj][1] * acc[ai][bj][m][1];
                    if (BOUT) { u32x4 w; w.x = cvt_pk_bf16(o0[0], o0[1]); w.y = cvt_pk_bf16(o0[2], o0[3]); w.z = cvt_pk_bf16(o1[0], o1[1]); w.w = cvt_pk_bf16(o1[2], o1[3]); __builtin_amdgcn_raw_buffer_store_b128(w, rOut, (unsigned)(offo + bj * HALF) * 2u, 0, PG8_RES_AUX); }
                    else { __builtin_amdgcn_raw_buffer_store_b128(__builtin_bit_cast(u32x4, o0), rOut, (unsigned)(offo + bj * HALF) * 4u, 0, 2); __builtin_amdgcn_raw_buffer_store_b128(__builtin_bit_cast(u32x4, o1), rOut, (unsigned)(offo + bj * HALF + 4) * 4u, 0, 2); }
                    if (XG) { ss += ((o0[0] * o0[0] + o0[1] * o0[1]) + (o0[2] * o0[2] + o0[3] * o0[3])) + ((o1[0] * o1[0] + o1[1] * o1[1]) + (o1[2] * o1[2] + o1[3] * o1[3]));
                        const f32x4 g0 = o0 * gm[bj][0], g1 = o1 * gm[bj][1];
                        u32x4 w; w.x = cvt_pk_bf16(g0[0], g0[1]); w.y = cvt_pk_bf16(g0[2], g0[3]); w.z = cvt_pk_bf16(g1[0], g1[1]); w.w = cvt_pk_bf16(g1[2], g1[3]);
                        st16_wt(rXg, (unsigned)(off + bj * HALF) * 2u, w); } }
                if (XG) { ss += __int_as_float(__builtin_amdgcn_ds_bpermute((lane ^ 16) << 2, __float_as_int(ss))); ss += __int_as_float(__builtin_amdgcn_ds_bpermute((lane ^ 32) << 2, __float_as_int(ss)));
                    if (fq == 0) atomicAdd((int*)ssq + row, __float2int_rn(ss * SSQ_FX)); } }
    }
};

template <class Epi, class Sched, bool ALIGN_EPI = false, bool SP2 = false>
__device__ __forceinline__ void gemm_phase(PG8_LAS unsigned char* lds, const Gemm g, const Sched& S, const Epi& E, int wave_id  ) {
    int tid_l; asm volatile("v_mbcnt_lo_u32_b32 %0, -1, 0\n\tv_mbcnt_hi_u32_b32 %0, -1, %0" : "=v"(tid_l)); tid_l += wave_id * 64;
    const int tid = tid_l, wid = wave_id, lane = tid & 63, wr = wid >> 2, wc = wid & 3, fr = lane & 15, fq = lane >> 4;
    const int K = g.K, nt = K / BK;
    unsigned voffA[2], voffB[2];
#pragma unroll
    for (int i = 0; i < 2; ++i) { int R, C; stage_rc(tid * 16 + i * 8192, R, C); const int Rb = Epi::PERM ? ((R & ~31) + perm32(R & 31)) : R;
        voffA[i] = (unsigned)(R * K + C) * 2u; voffB[i] = (unsigned)(Rb * K + C) * 2u; }
    const unsigned kstep = (unsigned)(BK * 2);
    const unsigned hstep = (unsigned)HALF * K * 2;
    const unsigned tstep = 2 * hstep;
    const unsigned ldsw = (unsigned)wid * 1024u;
    const int aoff = lds_byte(wr * 64 + fr, fq * 8), boff = lds_byte(wc * 32 + fr, fq * 8);
#define PG8_SA(b, h) (((b) * 2 + (h)) * HTB)
#define PG8_SB(b, h) ((4 + (b) * 2 + (h)) * HTB)
    const __amdgpu_buffer_rsrc_t rsrc_voffA = __builtin_amdgcn_make_buffer_rsrc((void*)g.A, 0, 0x7ffffff0, 0x00020000), rsrc_voffB = __builtin_amdgcn_make_buffer_rsrc((void*)g.Bt, 0, 0x7ffffff0, 0x00020000);
#ifndef PG8_A_AUX
#define PG8_A_AUX 0
#endif
#ifndef PG8_B_AUX
#define PG8_B_AUX 0
#endif
    constexpr int aux_voffA = PG8_A_AUX, aux_voffB = PG8_B_AUX;
#define PG8_STAGE(bufoff, goff, voff) do { _Pragma("unroll") for (int _i = 0; _i < 2; ++_i) \
        __builtin_amdgcn_raw_ptr_buffer_load_lds(rsrc_##voff, (PG8_LAS unsigned*)(lds + (bufoff) + ldsw + _i * 8192), 16, (voff)[_i], (goff), 0, aux_##voff); } while (0)
#define PG8_LDA(dst, b, h) do { _Pragma("unroll") for (int m = 0; m < 4; ++m) _Pragma("unroll") for (int k = 0; k < 2; ++k) dst[m][k] = *(const PG8_LAS bf16x8*)(lds + PG8_SA(b, h) + aoff + m * 2048 + k * 1024); } while (0)
#define PG8_LDB(dst, b, h) do { _Pragma("unroll") for (int n = 0; n < 2; ++n) _Pragma("unroll") for (int k = 0; k < 2; ++k) dst[n][k] = *(const PG8_LAS bf16x8*)(lds + PG8_SB(b, h) + boff + n * 2048 + k * 1024); } while (0)
#define PG8_MMA(ai, bj, At, Bt) do { __builtin_amdgcn_s_setprio(1); _Pragma("unroll") for (int m = 0; m < 4; ++m) _Pragma("unroll") for (int n = 0; n < 2; ++n) _Pragma("unroll") for (int k = 0; k < 2; ++k) \
        acc[ai][bj][m][n] = __builtin_amdgcn_mfma_f32_16x16x32_bf16(Bt[n][k], At[m][k], acc[ai][bj][m][n], 0, 0, 0); __builtin_amdgcn_s_setprio(0); } while (0)
#define PG8_WAIT_V(n) asm volatile("s_waitcnt vmcnt(" #n ")" ::: "memory")
#define PG8_WAIT_L(n) asm volatile("s_waitcnt lgkmcnt(" #n ")" ::: "memory")
#define PG8_BAR __builtin_amdgcn_s_barrier()
#define PG8_SCHED __builtin_amdgcn_sched_barrier(0)
    Unit cur, nxt; int ui = 0;
    if (!S.next(0, cur)) return;
    f32x4 acc[2][2][4][2];
#pragma unroll
    for (int a = 0; a < 2; ++a)
#pragma unroll
        for (int b = 0; b < 2; ++b)
#pragma unroll
            for (int m = 0; m < 4; ++m)
#pragma unroll
                for (int n = 0; n < 2; ++n) acc[a][b][m][n] = (f32x4){0.f, 0.f, 0.f, 0.f};
    bf16x8 At[4][2], B0[2][2], B1[2][2];
    unsigned cA = (unsigned)cur.pm * g.a_panel_bytes, cB = (unsigned)cur.pn * tstep;
    S.a_ready(cur);
    if constexpr (SP2) {
        PG8_STAGE(PG8_SB(0, 0), cB, voffB); PG8_STAGE(PG8_SB(0, 1), cB + hstep, voffB); PG8_STAGE(PG8_SA(0, 0), cA, voffA); PG8_STAGE(PG8_SA(0, 1), cA + hstep, voffA);
        if (wr == 1) PG8_BAR;
        PG8_WAIT_V(2); PG8_BAR;
        PG8_STAGE(PG8_SB(1, 0), cB + kstep, voffB); PG8_STAGE(PG8_SA(1, 0), cA + kstep, voffA); PG8_STAGE(PG8_SB(1, 1), cB + hstep + kstep, voffB);
        PG8_WAIT_V(6); PG8_BAR;
    } else {
        PG8_STAGE(PG8_SB(0, 0), cB, voffB); PG8_STAGE(PG8_SA(0, 0), cA, voffA); PG8_STAGE(PG8_SB(0, 1), cB + hstep, voffB); PG8_STAGE(PG8_SA(0, 1), cA + hstep, voffA);
        if (wr == 1) PG8_BAR;
        PG8_WAIT_V(4); PG8_BAR;
        PG8_STAGE(PG8_SB(1, 0), cB + kstep, voffB); PG8_STAGE(PG8_SA(1, 0), cA + kstep, voffA); PG8_STAGE(PG8_SB(1, 1), cB + hstep + kstep, voffB);
        PG8_WAIT_V(6); PG8_BAR;
    }
    for (;;) {
        const bool has_next = S.next(ui + 1, nxt);
        const unsigned nA = has_next ? (unsigned)nxt.pm * g.a_panel_bytes : cA, nB = has_next ? (unsigned)nxt.pn * tstep : cB;
        for (int t = 0; t < nt; t += 2) {
            const bool last = (t == nt - 2);
            const unsigned a1 = cA + (unsigned)(t + 1) * kstep;
            const unsigned a2 = last ? nA : cA + (unsigned)(t + 2) * kstep, b2 = last ? nB : cB + (unsigned)(t + 2) * kstep;
            const unsigned a3 = a2 + kstep, b3 = b2 + kstep;
            if (last && has_next) S.a_ready(nxt);
            if constexpr (SP2) {
            PG8_LDB(B0, 0, 0); PG8_LDB(B1, 0, 1); PG8_SCHED; PG8_LDA(At, 0, 0); PG8_STAGE(PG8_SA(1, 1), a1 + hstep, voffA);
            PG8_WAIT_V(8); PG8_WAIT_L(0); PG8_BAR; PG8_MMA(0, 0, At, B0); PG8_MMA(0, 1, At, B1); PG8_BAR; PG8_SCHED;
            PG8_LDA(At, 0, 1); PG8_STAGE(PG8_SB(0, 0), b2, voffB); PG8_STAGE(PG8_SB(0, 1), b2 + hstep, voffB); PG8_STAGE(PG8_SA(0, 0), a2, voffA);
            PG8_WAIT_V(8); PG8_WAIT_L(0); PG8_BAR; PG8_MMA(1, 0, At, B0); PG8_MMA(1, 1, At, B1); PG8_BAR; PG8_SCHED;
            PG8_LDB(B0, 1, 0); PG8_LDB(B1, 1, 1); PG8_SCHED; PG8_LDA(At, 1, 0); PG8_STAGE(PG8_SA(0, 1), a2 + hstep, voffA);
            PG8_WAIT_V(8); PG8_WAIT_L(0); PG8_BAR; PG8_MMA(0, 0, At, B0); PG8_MMA(0, 1, At, B1); PG8_BAR; PG8_SCHED;
            PG8_LDA(At, 1, 1); PG8_STAGE(PG8_SB(1, 0), b3, voffB); PG8_STAGE(PG8_SB(1, 1), b3 + hstep, voffB); PG8_STAGE(PG8_SA(1, 0), a3, voffA);
            PG8_WAIT_V(8); PG8_WAIT_L(0); PG8_BAR; PG8_MMA(1, 0, At, B0); PG8_MMA(1, 1, At, B1); PG8_BAR; PG8_SCHED;
            } else {
            PG8_LDB(B0, 0, 0); PG8_SCHED; PG8_LDA(At, 0, 0); PG8_STAGE(PG8_SA(1, 1), a1 + hstep, voffA);
            PG8_WAIT_L(8); PG8_BAR; PG8_WAIT_L(0); PG8_MMA(0, 0, At, B0); PG8_BAR; PG8_SCHED;
            PG8_LDB(B1, 0, 1); PG8_STAGE(PG8_SB(0, 0), b2, voffB);
            PG8_BAR; PG8_WAIT_L(0); PG8_MMA(0, 1, At, B1); PG8_BAR;
            PG8_LDA(At, 0, 1); PG8_STAGE(PG8_SA(0, 0), a2, voffA);
            PG8_BAR; PG8_WAIT_L(0); PG8_MMA(1, 0, At, B0); PG8_BAR; PG8_SCHED;
            PG8_STAGE(PG8_SB(0, 1), b2 + hstep, voffB);
            PG8_WAIT_V(6); PG8_BAR; PG8_MMA(1, 1, At, B1); PG8_BAR;
            PG8_LDB(B0, 1, 0); PG8_SCHED; PG8_LDA(At, 1, 0); PG8_STAGE(PG8_SA(0, 1), a2 + hstep, voffA);
            PG8_WAIT_L(8); PG8_BAR; PG8_WAIT_L(0); PG8_MMA(0, 0, At, B0); PG8_BAR; PG8_SCHED;
            PG8_LDB(B1, 1, 1); PG8_STAGE(PG8_SB(1, 0), b3, voffB);
            PG8_BAR; PG8_WAIT_L(0); PG8_MMA(0, 1, At, B1); PG8_BAR;
            PG8_LDA(At, 1, 1); PG8_STAGE(PG8_SA(1, 0), a3, voffA);
            PG8_BAR; PG8_WAIT_L(0); PG8_MMA(1, 0, At, B0); PG8_BAR; PG8_SCHED;
            PG8_STAGE(PG8_SB(1, 1), b3 + hstep, voffB);
            PG8_WAIT_V(6); PG8_BAR; PG8_MMA(1, 1, At, B1); PG8_BAR;
            }
        }
        if constexpr (ALIGN_EPI) { if (wr == 0) PG8_BAR; }
        if constexpr (!Epi::AFTER_DRAIN) { E(acc, cur, wr, wc, fr, fq); S.done(cur); }
        if (!has_next) break;
#pragma unroll
        for (int a = 0; a < 2; ++a)
#pragma unroll
            for (int b = 0; b < 2; ++b)
#pragma unroll
                for (int m = 0; m < 4; ++m)
#pragma unroll
                    for (int n = 0; n < 2; ++n) acc[a][b][m][n] = (f32x4){0.f, 0.f, 0.f, 0.f};
        cur = nxt; cA = nA; cB = nB; ++ui;
        if constexpr (ALIGN_EPI) { if (wr == 1) PG8_BAR; }
    }
    PG8_WAIT_V(0);
    if constexpr (!ALIGN_EPI) { if (wr == 0) PG8_BAR; }
    PG8_BAR;
    if constexpr (Epi::AFTER_DRAIN) { E.fused(acc, cur, wr, wc, fr, fq, lds, wid, lane); S.done(cur); }
#undef PG8_SA
#undef PG8_SB
#undef PG8_STAGE
#undef PG8_LDA
#undef PG8_LDB
#undef PG8_MMA
#undef PG8_WAIT_V
#undef PG8_WAIT_L
#undef PG8_BAR
#undef PG8_SCHED
}
}

#ifndef PG8_SP2
#define PG8_SP2 true
#endif
#ifndef PG8_ALIGN
#define PG8_ALIGN true
#endif
constexpr int NWAVES = 8;
constexpr int BATCH = 4, SEQ = 4096, D = 1024, M = BATCH * SEQ, NIN = 2816, FF = 4096, NLAYER = 2, ADA = 6 * D;
constexpr int C_AQ = 0, C_AK = 512, C_AV = 640, C_RQ = 768, C_RK = 1280, C_RV = 1792, C_RG = 2304;
constexpr float EPS = 1e-6f;

constexpr size_t MiB = 1u << 20;
constexpr size_t WS_CTL = 0, CTL_ZERO_BYTES = 1 * MiB;
constexpr size_t WS_SW = 64 * 1024;
constexpr size_t WS_SSQ = 768 * 1024;
constexpr size_t WS_ADA = 512 * 1024;
constexpr size_t WS_W = 1 * MiB, W_LAYER = 47 * MiB / 2;
constexpr size_t WO_IN = 0, WO_OUT = 11 * MiB / 2, WO_1 = 15 * MiB / 2, WO_2 = 31 * MiB / 2;
constexpr size_t WS_XN = 48 * MiB;
constexpr size_t WS_H = 80 * MiB;
constexpr size_t WS_PROJ = 80 * MiB;
constexpr size_t WS_MIX = WS_H + 256u * NIN * 2;
constexpr size_t WS_KV = 208 * MiB;
constexpr size_t WS_PREV = 240 * MiB;
constexpr size_t WS_END = 256 * MiB;
static_assert(WS_W + NLAYER * W_LAYER <= WS_XN && WS_XN + (size_t)M * D * 2 <= WS_H && WS_H + (size_t)M * FF * 2 <= WS_KV && WS_PREV + 512u * 16384 * 2 <= WS_END, "d_ws map");
constexpr int CW_TMO = 0, CW_CODE = 1;
constexpr int CW_BAR = 4096;
constexpr int CW_SWCNT = 320;
constexpr int CW_TEAM = 65536;
constexpr int CW_XCC = CW_TEAM + (NLAYER + 1) * 64 * 64;
constexpr int CW_XEV = 98304;
constexpr int CW_MIX = 8192;

constexpr int RING_OFF = 0, RING_BYTES = 131072;
constexpr int LDSCTL_OFF = RING_BYTES, MISC_OFF = LDSCTL_OFF + 320;
constexpr int RSTG_OFF = RING_BYTES + 1024;
constexpr int LDS_BYTES = 163840;
static_assert(MISC_OFF + 256 <= RSTG_OFF && RSTG_OFF + 8 * 2560 <= LDS_BYTES, "LDS map");

#define GAS __attribute__((address_space(1)))
#define LAS __attribute__((address_space(3)))
typedef unsigned short bf16;
typedef unsigned v4u __attribute__((ext_vector_type(4)));
typedef float f32x4 __attribute__((ext_vector_type(4)));
typedef short bf16x8 __attribute__((ext_vector_type(8)));
typedef GAS unsigned gu32;
typedef GAS unsigned long long gu64;
#define RLX_AGENT __ATOMIC_RELAXED, __HIP_MEMORY_SCOPE_AGENT
#define LDS_WAIT() asm volatile("s_waitcnt lgkmcnt(0)" ::: "memory")
#define VM_WAIT() asm volatile("s_waitcnt vmcnt(0)" ::: "memory")
__device__ __forceinline__ unsigned long long rt() { return __builtin_amdgcn_s_memrealtime(); }

__device__ __forceinline__ unsigned pk2(float lo, float hi) { typedef float f2_ __attribute__((ext_vector_type(2))); typedef __bf16 b2_ __attribute__((ext_vector_type(2))); f2_ v = {lo, hi}; b2_ b = __builtin_convertvector(v, b2_); return __builtin_bit_cast(unsigned, b); }
__device__ __forceinline__ unsigned f2bf(float f) { return pk2(f, f) & 0xffffu; }

#define XB_TMO      128
#define XB_XCNT(j)  (256  + 64 * (j))
#define XB_XSUB(j)  (1280 + 64 * (j))
#define XB_XGEN(j)  (2304 + 64 * (j))
#define XB_TOP      3328
#define XB_TOPGEN   3392
#define XCD_BAR_WORDS 3456
#define XB_SPIN_CAP (1u << 18)

__device__ __forceinline__ unsigned xb_ld(unsigned* p)              { return __hip_atomic_load(p, __ATOMIC_RELAXED, __HIP_MEMORY_SCOPE_AGENT); }
__device__ __forceinline__ unsigned xb_add(unsigned* p, unsigned v) { return __hip_atomic_fetch_add(p, v, __ATOMIC_RELAXED, __HIP_MEMORY_SCOPE_AGENT); }
__device__ __forceinline__ unsigned xb_xcc_id() { return (unsigned)__builtin_amdgcn_s_getreg((3 << 11) | 20) & 0xFu; }
#define XB_SPIN(cond, bar) do { unsigned _sp = 0; while (cond) { __builtin_amdgcn_s_sleep(1); \
    if ((++_sp & 255u) == 0u) { if (xb_ld(&(bar)[XB_TMO])) break; if (_sp > XB_SPIN_CAP) { atomicAdd(&(bar)[XB_TMO], 1u); break; } } } } while (0)

struct XcdBarrier {
    unsigned* bar; unsigned x;
    volatile LAS unsigned* st;
};

__device__ __forceinline__ XcdBarrier xcd_barrier_post(unsigned* bar, volatile LAS unsigned* st, int tid) {
    XcdBarrier b; b.bar = bar; b.x = xb_xcc_id(); b.st = st;
    if (tid == 0) (void)xb_add(&bar[XB_XCNT(b.x)], 1u);
    return b;
}
__device__ __forceinline__ void xcd_barrier_complete(unsigned* bar, unsigned x, unsigned& nloc, unsigned& nx) {
    const unsigned G = gridDim.x * gridDim.y * gridDim.z;
    unsigned sum, cnt, mine, sp = 0u;
    for (;;) {
        sum = 0u; cnt = 0u; mine = 0u;
#pragma unroll
        for (unsigned j = 0; j < 16; ++j) { const unsigned c = xb_ld(&bar[XB_XCNT(j)]); sum += c; cnt += (c > 0u) ? 1u : 0u; mine = (j == x) ? c : mine; }
        if (sum == G) break;
        __builtin_amdgcn_s_sleep(1);
        if ((++sp & 255u) == 0u) { if (xb_ld(&bar[XB_TMO])) break; if (sp > XB_SPIN_CAP) { atomicAdd(&bar[XB_TMO], 1u); break; } }
    }
    nloc = mine > 0u ? mine : 1u; nx = cnt > 0u ? cnt : 1u;
}

__device__ __forceinline__ void xcd_barrier(const XcdBarrier& b, int tid) {
    asm volatile("s_waitcnt vmcnt(0)" ::: "memory");
    __syncthreads();
    if (tid == 0) {
        unsigned* bar = b.bar;
        __builtin_amdgcn_s_waitcnt(0);
        unsigned nloc = b.st[0], nx = b.st[1];
        if (nloc == 0u) { xcd_barrier_complete(bar, b.x, nloc, nx); b.st[0] = nloc; b.st[1] = nx; }
        const unsigned old = xb_add(&bar[XB_XSUB(b.x)], 1u);
        const unsigned gen = old / nloc;
        if (old + 1u == (gen + 1u) * nloc) {
            __builtin_amdgcn_fence(__ATOMIC_RELEASE, "agent");
            asm volatile("s_waitcnt vmcnt(0)" ::: "memory");
            const unsigned og = xb_add(&bar[XB_TOP], 1u);
            const unsigned tg = og / nx;
            if (og + 1u == (tg + 1u) * nx) xb_add(&bar[XB_TOPGEN], 1u);
            else XB_SPIN(xb_ld(&bar[XB_TOPGEN]) == tg, bar);
            __builtin_amdgcn_fence(__ATOMIC_ACQUIRE, "agent");
            xb_add(&bar[XB_XGEN(b.x)], 1u);
            asm volatile("s_waitcnt vmcnt(0)" ::: "memory");
        } else {
            XB_SPIN(xb_ld(&bar[XB_XGEN(b.x)]) == gen, bar);
            __builtin_amdgcn_fence(__ATOMIC_ACQUIRE, "agent");
            asm volatile("s_waitcnt vmcnt(0)" ::: "memory");
        }
    }
    __syncthreads();
}

struct Args { const float* in[14]; float* out; unsigned char* ws; };
typedef const __attribute__((address_space(4))) Args* ArgsP;
__device__ __forceinline__ ArgsP get_args() { ArgsP p = (ArgsP)__builtin_amdgcn_kernarg_segment_ptr(); asm volatile("" : "+s"(p)); return p; }
struct Frame {
    LAS unsigned char* lds;
    ArgsP ap;
    int tid, lane, wave;
    int vcu, G;
    int wave0, vcu0, G0;
};
#define F_X(F) ((F).ap->in[0])
#define F_C(F) ((F).ap->in[1])
#define F_N1G(F) ((F).ap->in[2])
#define F_N2G(F) ((F).ap->in[3])
#define F_WADA(F) ((F).ap->in[4])
#define F_BADA(F) ((F).ap->in[5])
#define F_WIN(F) ((F).ap->in[6])
#define F_QNG(F) ((F).ap->in[7])
#define F_KNG(F) ((F).ap->in[8])
#define F_SINKS(F) ((F).ap->in[9])
#define F_RNG(F) ((F).ap->in[10])
#define F_WOUT(F) ((F).ap->in[11])
#define F_W1(F) ((F).ap->in[12])
#define F_W2(F) ((F).ap->in[13])
#define F_OUT(F) ((F).ap->out)
#define F_WS(F) ((F).ap->ws)
#define F_ADA(F) ((float*)((F).ap->ws + WS_ADA))
#define LAUNDER(F) do { (F).ap = get_args(); int l_; asm volatile("v_mbcnt_lo_u32_b32 %0, -1, 0\n\tv_mbcnt_hi_u32_b32 %0, -1, %0" : "=v"(l_)); int w_ = (F).wave0, c_ = (F).vcu0, g_ = (F).G0; asm volatile("" : "+s"(w_), "+s"(c_), "+s"(g_)); (F).lane = l_; (F).wave = w_; (F).vcu = c_; (F).G = g_; (F).tid = w_ * 64 + l_; } while (0)
__device__ __forceinline__ float bf2f(unsigned short u) { return __uint_as_float(((unsigned)u) << 16); }
__device__ __forceinline__ float bflo(unsigned u) { return __uint_as_float(u << 16); }
__device__ __forceinline__ float bfhi(unsigned u) { return __uint_as_float(u & 0xffff0000u); }
__device__ __forceinline__ void unpack8(const v4u w, float* f) { f[0] = bflo(w.x); f[1] = bfhi(w.x); f[2] = bflo(w.y); f[3] = bfhi(w.y); f[4] = bflo(w.z); f[5] = bfhi(w.z); f[6] = bflo(w.w); f[7] = bfhi(w.w); }
__device__ __forceinline__ float shx(float v, int mask, int lane) { return __int_as_float(__builtin_amdgcn_ds_bpermute((lane ^ mask) << 2, __float_as_int(v))); }
__device__ __forceinline__ float wave_sum(float v, int lane) {
#pragma unroll
    for (int o = 1; o < 64; o <<= 1) v += shx(v, o, lane);
    return v;
}
__device__ __forceinline__ float ret_log_gamma(int h) { return h == 0 ? -0.031748698314580301f : h == 1 ? -0.015748356968139168f : h == 2 ? -0.0078431774610258928f : -0.0039138993211363287f; }

__device__ __forceinline__ void p0_transpose_item(const float* W, int K, int N, bf16* WT, int row_off, LAS float* scr, int item, int lane) {
    const int nblk = N / 32, kb = item / nblk, nb = item % nblk, k0 = 64 * kb, n0 = 32 * nb;
    f32x4 wv[8];
#pragma unroll
    for (int i = 0; i < 8; ++i) wv[i] = __builtin_nontemporal_load((const GAS f32x4*)(W + (size_t)(k0 + 8 * i + (lane >> 3)) * N + n0 + 4 * (lane & 7)));
#pragma unroll
    for (int i = 0; i < 8; ++i) { LAS float* d = scr + (8 * i + (lane >> 3)) * 33 + 4 * (lane & 7); d[0] = wv[i].x; d[1] = wv[i].y; d[2] = wv[i].z; d[3] = wv[i].w; }
    LDS_WAIT(); asm volatile("" ::: "memory");
    const int c = lane & 7;
#pragma unroll
    for (int j = 0; j < 4; ++j) { const int n = (lane >> 3) + 8 * j; const LAS float* s = scr + (8 * c) * 33 + n;
        v4u o; o.x = pk2(s[0 * 33], s[1 * 33]); o.y = pk2(s[2 * 33], s[3 * 33]); o.z = pk2(s[4 * 33], s[5 * 33]); o.w = pk2(s[6 * 33], s[7 * 33]);
        *(GAS v4u*)(WT + (size_t)(row_off + n0 + n) * K + k0 + 8 * c) = o; }
    LDS_WAIT(); asm volatile("" ::: "memory");
}
constexpr int ADA_KS = 32, ADA_NKS = D / ADA_KS, ADA_NCB = ADA / 256;
__device__ __forceinline__ void p0_ada_item(Frame& F, int item, LAS float* scr) {
    const int ks = item % ADA_NKS, cb = (item / ADA_NKS) % ADA_NCB, l = item / (ADA_NKS * ADA_NCB), k0 = ks * ADA_KS, j = cb * 256 + 4 * F.lane;
    const GAS f32x4* w = (const GAS f32x4*)(F_WADA(F) + ((size_t)l * D + k0) * ADA + j);
    f32x4 wv[ADA_KS];
#pragma unroll
    for (int k = 0; k < ADA_KS; ++k) wv[k] = __builtin_nontemporal_load(w + (size_t)k * (ADA / 4));
    if (F.lane < ADA_KS) {
#pragma unroll
        for (int b = 0; b < BATCH; ++b) { const float cv = F_C(F)[b * D + k0 + F.lane]; scr[F.lane * 4 + b] = cv / (1.0f + __expf(-cv)); } }
    LDS_WAIT(); asm volatile("" ::: "memory");
    f32x4 a[BATCH];
#pragma unroll
    for (int b = 0; b < BATCH; ++b) a[b] = (f32x4){0.f, 0.f, 0.f, 0.f};
#pragma unroll
    for (int k = 0; k < ADA_KS; ++k) { const f32x4 cv = *(const LAS f32x4*)(scr + k * 4); a[0] += wv[k] * cv.x; a[1] += wv[k] * cv.y; a[2] += wv[k] * cv.z; a[3] += wv[k] * cv.w; }
    if (ks == 0) { const f32x4 bv = *(const GAS f32x4*)(F_BADA(F) + l * ADA + j);
#pragma unroll
        for (int b = 0; b < BATCH; ++b) a[b] += bv; }
    float* ad = F_ADA(F) + (size_t)(l * BATCH) * ADA + j;
#pragma unroll
    for (int b = 0; b < BATCH; ++b) { int* ai = (int*)(ad + b * ADA); atomicAdd(ai, __float2int_rn(a[b].x * pg8::ADA_FX)); atomicAdd(ai + 1, __float2int_rn(a[b].y * pg8::ADA_FX)); atomicAdd(ai + 2, __float2int_rn(a[b].z * pg8::ADA_FX)); atomicAdd(ai + 3, __float2int_rn(a[b].w * pg8::ADA_FX)); }
    LDS_WAIT(); asm volatile("" ::: "memory");
}
__device__ __forceinline__ void p0a_phase(Frame& F) {
    LAUNDER(F);
    LAS float* scr = (LAS float*)(F.lds + RING_OFF + F.wave * 16384);
    if (F.wave == 0) for (int it = F.vcu; it < 8 * ADA_NKS; it += F.G) p0_ada_item(F, it, scr);
}
__device__ __forceinline__ void p0_tr_dispatch(Frame& F, int r, LAS float* scr) {
    constexpr int I_IN = (D / 64) * (NIN / 32), I_O = (D / 64) * (D / 32), I_1 = (D / 64) * (FF / 32), I_2 = (FF / 64) * (D / 32), I_L = I_IN + I_O + I_1 + I_2;
    const int l = r / I_L; r -= l * I_L;
    bf16* wl = (bf16*)(F_WS(F) + WS_W + (size_t)l * W_LAYER);
    if (r < I_IN) { p0_transpose_item(F_WIN(F) + (size_t)l * D * NIN, D, NIN, wl + WO_IN / 2, 0, scr, r, F.lane); return; } r -= I_IN;
    if (r < I_O) { p0_transpose_item(F_WOUT(F) + (size_t)l * D * D, D, D, wl + WO_OUT / 2, 0, scr, r, F.lane); return; } r -= I_O;
    if (r < I_1) { p0_transpose_item(F_W1(F) + (size_t)l * D * FF, D, FF, wl + WO_1 / 2, 0, scr, r, F.lane); return; } r -= I_1;
    p0_transpose_item(F_W2(F) + (size_t)l * FF * D, FF, D, wl + WO_2 / 2, 0, scr, r, F.lane);
}
constexpr int TR_I_IN = (D / 64) * (NIN / 32), TR_I_O = (D / 64) * (D / 32), TR_I_L = TR_I_IN + TR_I_O + (D / 64) * (FF / 32) + (FF / 64) * (D / 32);
__device__ __forceinline__ void p0b_items(Frame& F) {
    LAUNDER(F);
    LAS float* scr = (LAS float*)(F.lds + RING_OFF + F.wave * 16384);
    const int gw = F.vcu * NWAVES + F.wave, NGW = F.G * NWAVES;
    constexpr int I_ADA = NLAYER * ADA_NCB * ADA_NKS - 8 * ADA_NKS;
    constexpr int NTR = NLAYER * TR_I_L;
    for (int it = gw; it < I_ADA + NTR; it += NGW) {
        if (it < I_ADA) { p0_ada_item(F, it + 8 * ADA_NKS, scr); continue; }
        p0_tr_dispatch(F, it - I_ADA, scr);
    }
}
__device__ __forceinline__ void sw_phase(Frame& F, int part, int nparts) {
    LAUNDER(F);
    const int gw = part * NWAVES + F.wave, NGW = nparts * NWAVES, lane = F.lane;
#pragma unroll 1
    for (int v = 0; v < 3; ++v) {
        const int l = (v == 0) ? 0 : 1, N = (v == 1) ? NIN : FF;
        const bf16* Wt = (const bf16*)(F_WS(F) + WS_W + (size_t)l * W_LAYER) + ((v == 1) ? WO_IN : WO_1) / 2;
        const float* sh = F_ADA(F) + (size_t)l * BATCH * ADA + ((v == 1) ? 0 : 3 * D);
        float* SW = (float*)(F_WS(F) + WS_SW) + (size_t)v * BATCH * 4096;
        f32x4 s[BATCH][4];
#pragma unroll
        for (int b = 0; b < BATCH; ++b)
#pragma unroll
            for (int j = 0; j < 4; ++j) s[b][j] = pg8::ld_ada4(sh + (size_t)b * ADA + (j >> 1) * 512 + lane * 8 + (j & 1) * 4);
        for (int n = gw; n < N; n += NGW) {
            const v4u w0 = *(const GAS v4u*)(Wt + (size_t)n * D + lane * 8), w1 = *(const GAS v4u*)(Wt + (size_t)n * D + 512 + lane * 8);
            float f[16]; unpack8(w0, f); unpack8(w1, f + 8);
            float acc[BATCH];
#pragma unroll
            for (int b = 0; b < BATCH; ++b) { acc[b] = 0.f;
#pragma unroll
                for (int j = 0; j < 4; ++j) acc[b] += (f[4 * j] * s[b][j].x + f[4 * j + 1] * s[b][j].y) + (f[4 * j + 2] * s[b][j].z + f[4 * j + 3] * s[b][j].w); }
#pragma unroll
            for (int b = 0; b < BATCH; ++b) acc[b] = wave_sum(acc[b], lane);
            if (lane < BATCH) SW[(size_t)lane * 4096 + n] = (lane == 0) ? acc[0] : (lane == 1) ? acc[1] : (lane == 2) ? acc[2] : acc[3];
        }
    }
}
__device__ __forceinline__ void xn_phase(Frame& F, const float* xsrc, const float* g, const float* shift, const float* scale, bf16* XN) {
    LAUNDER(F);
    const int gw = F.vcu * NWAVES + F.wave, NGW = F.G * NWAVES;
    for (int rb = gw; rb < M / 8; rb += NGW) {
        const int b = (rb * 8) / SEQ;
        f32x4 gm[4], sh[4];
#pragma unroll
        for (int j = 0; j < 4; ++j) { const int col = 256 * j + 4 * F.lane; const f32x4 gg = *(const f32x4*)(g + col), sc = pg8::ld_ada4(scale + (size_t)b * ADA + col); gm[j] = gg * (sc + 1.0f); sh[j] = pg8::ld_ada4(shift + (size_t)b * ADA + col); }
#pragma unroll 2
        for (int r = 0; r < 8; ++r) { const size_t row = (size_t)rb * 8 + r;
            const GAS f32x4* xr = (const GAS f32x4*)(xsrc + row * D) + F.lane;
            f32x4 v[4]; float s = 0.f;
#pragma unroll
            for (int j = 0; j < 4; ++j) { v[j] = __builtin_nontemporal_load(xr + 64 * j); s += (v[j].x * v[j].x + v[j].y * v[j].y) + (v[j].z * v[j].z + v[j].w * v[j].w); }
            const float rstd = 1.0f / sqrtf(wave_sum(s, F.lane) * (1.0f / D) + EPS);
            GAS unsigned long long* o8 = (GAS unsigned long long*)(XN + row * D) + F.lane;
#pragma unroll
            for (int j = 0; j < 4; ++j) { const f32x4 o = v[j] * rstd * gm[j] + sh[j]; o8[64 * j] = (unsigned long long)pk2(o.x, o.y) | ((unsigned long long)pk2(o.z, o.w) << 32); }
        }
    }
}

__device__ __forceinline__ void ret_scan(Frame& F, const float* KV, bf16* PREV) {
    LAUNDER(F);
    const int gt = F.vcu * (NWAVES * 64) + F.tid, NT = F.G * NWAVES * 64;
    for (int idx = gt; idx < BATCH * 4 * 8192; idx += NT) {
        const int de = idx & 8191, h = (idx >> 13) & 3, b = idx >> 15;
        const float cd = __expf(128.0f * ret_log_gamma(h));
        float s0 = 0.f, s1 = 0.f;
        const size_t base = ((size_t)(b * 32) * 4 + h) * 16384 + 2 * de;
        typedef float f32x2_t __attribute__((ext_vector_type(2)));
        f32x2_t kv[32];
#pragma unroll
        for (int n = 0; n < 32; ++n) kv[n] = __builtin_nontemporal_load((const GAS f32x2_t*)(KV + base + (size_t)n * 65536));
#pragma unroll
        for (int n = 0; n < 32; ++n) {
            const float p0 = cd * s0, p1 = cd * s1;
            *(GAS unsigned*)(PREV + base + (size_t)n * 65536) = pk2(p0, p1);
            s0 = p0 + kv[n].x; s1 = p1 + kv[n].y;
        }
    }
}

typedef float f32x16 __attribute__((ext_vector_type(16)));
typedef short s16x4 __attribute__((ext_vector_type(4)));
typedef short v4i16_t __attribute__((ext_vector_type(4)));
#define MFMA32(a, b, c) __builtin_amdgcn_mfma_f32_32x32x16_bf16((a), (b), (c), 0, 0, 0)
constexpr float LOG2E = 1.4426950408889634f;
__device__ __forceinline__ int crow(int r, int hi) { return (r & 3) + 8 * (r >> 2) + 4 * hi; }
__device__ __forceinline__ s16x4 vtr(const LAS unsigned char* p) { return __builtin_bit_cast(s16x4, __builtin_amdgcn_ds_read_tr16_b64_v4i16((LAS v4i16_t*)p)); }
__device__ __forceinline__ bf16x8 vfrag(const LAS unsigned char* p) { const s16x4 lo = vtr(p), hi = vtr(p + 512); return (bf16x8){lo[0], lo[1], lo[2], lo[3], hi[0], hi[1], hi[2], hi[3]}; }
__device__ __forceinline__ unsigned cvtpk(float lo, float hi) { typedef float f2 __attribute__((ext_vector_type(2))); typedef __bf16 b2 __attribute__((ext_vector_type(2))); f2 v = {lo, hi}; b2 b = __builtin_convertvector(v, b2); return __builtin_bit_cast(unsigned, b); }
__device__ __forceinline__ bf16x8 pack8(const f32x16& x, int s) {
    v4u p; p.x = cvtpk(x[8 * s], x[8 * s + 1]); p.y = cvtpk(x[8 * s + 2], x[8 * s + 3]); p.z = cvtpk(x[8 * s + 4], x[8 * s + 5]); p.w = cvtpk(x[8 * s + 6], x[8 * s + 7]);
    return __builtin_bit_cast(bf16x8, p);
}


__device__ __forceinline__ void mix_publish(int tid, unsigned* c0, unsigned* c1) {
    asm volatile("s_waitcnt vmcnt(0)" ::: "memory"); __syncthreads();
    if (tid == 0) { __builtin_amdgcn_fence(__ATOMIC_RELEASE, "agent"); asm volatile("s_waitcnt vmcnt(0)" ::: "memory");
        __hip_atomic_fetch_add(c0, 1u, __ATOMIC_RELAXED, __HIP_MEMORY_SCOPE_AGENT); if (c1) __hip_atomic_fetch_add(c1, 1u, __ATOMIC_RELAXED, __HIP_MEMORY_SCOPE_AGENT); }
}
__device__ __forceinline__ void mix_publish_xcc(int tid, unsigned* ev  , unsigned nloc, unsigned* c0, unsigned* c1) {
    asm volatile("s_waitcnt vmcnt(0)" ::: "memory"); __syncthreads();
    if (tid == 0) {
        const unsigned old = __hip_atomic_fetch_add(ev, 1u, __ATOMIC_RELAXED, __HIP_MEMORY_SCOPE_AGENT);
        if (old + 1u == nloc) { __builtin_amdgcn_fence(__ATOMIC_RELEASE, "agent"); asm volatile("s_waitcnt vmcnt(0)" ::: "memory");
            __hip_atomic_store(ev + 64, 1u, __ATOMIC_RELAXED, __HIP_MEMORY_SCOPE_AGENT); }
        else { unsigned sp = 0; while (__hip_atomic_load(ev + 64, __ATOMIC_RELAXED, __HIP_MEMORY_SCOPE_AGENT) == 0u) { __builtin_amdgcn_s_sleep(1); if (++sp > (1u << 22)) break; } }
        __hip_atomic_fetch_add(c0, 1u, __ATOMIC_RELAXED, __HIP_MEMORY_SCOPE_AGENT); if (c1) __hip_atomic_fetch_add(c1, 1u, __ATOMIC_RELAXED, __HIP_MEMORY_SCOPE_AGENT); }
}
__device__ __forceinline__ void mix_wait(int wave, unsigned* c0, unsigned w0, unsigned* c1, unsigned w1) {
    if (wave == 0) { unsigned sp = 0;
        asm volatile("buffer_inv sc1" ::: "memory");
        for (;;) { const unsigned a = (unsigned)__builtin_amdgcn_readfirstlane((int)__hip_atomic_load(c0, __ATOMIC_RELAXED, __HIP_MEMORY_SCOPE_AGENT));
            const unsigned b = c1 ? (unsigned)__builtin_amdgcn_readfirstlane((int)__hip_atomic_load(c1, __ATOMIC_RELAXED, __HIP_MEMORY_SCOPE_AGENT)) : w1;
            if (a >= w0 && b >= w1) break; __builtin_amdgcn_s_sleep(2); if (++sp > (1u << 22)) break; }
        asm volatile("s_waitcnt vmcnt(0)" ::: "memory"); }
    __syncthreads();
}
constexpr size_t PANEL_ELEMS = 1u << 20;
__device__ __forceinline__ const bf16* PRW(const bf16* PROJ, size_t row) { return PROJ + (row >> 8) * PANEL_ELEMS + (row & 255) * NIN; }
__device__ __forceinline__ bf16* MXW(bf16* MIX, size_t row) { return MIX + (row >> 8) * PANEL_ELEMS + (row & 255) * D; }
__device__ __forceinline__ void team_sync(int tid, int wave, unsigned* cnt, unsigned want, bool same_xcc, unsigned* guard = nullptr, unsigned gwant = 0u) {
    asm volatile("s_waitcnt vmcnt(0)" ::: "memory"); __syncthreads();
    if (wave == 0) {
        if (tid == 0) { if (!same_xcc) { __builtin_amdgcn_fence(__ATOMIC_RELEASE, "agent"); asm volatile("s_waitcnt vmcnt(0)" ::: "memory"); }
            __hip_atomic_fetch_add(cnt, 1u, __ATOMIC_RELAXED, __HIP_MEMORY_SCOPE_AGENT); }
        unsigned sp = 0;
        asm volatile("buffer_inv sc1" ::: "memory");
        for (;;) { const unsigned a = (unsigned)__builtin_amdgcn_readfirstlane((int)__hip_atomic_load(cnt, __ATOMIC_RELAXED, __HIP_MEMORY_SCOPE_AGENT));
            const unsigned g = guard ? (unsigned)__builtin_amdgcn_readfirstlane((int)__hip_atomic_load(guard, __ATOMIC_RELAXED, __HIP_MEMORY_SCOPE_AGENT)) : gwant;
            if (a >= want && g >= gwant) break; __builtin_amdgcn_s_sleep(1); if (++sp > (1u << 22)) break; }
        asm volatile("s_waitcnt vmcnt(0)" ::: "memory"); }
    __syncthreads();
}
__device__ __forceinline__ void attn_mfma(Frame& F, int layer, const bf16* PROJ, bf16* MIX) {
    LAUNDER(F);
    const int tid = F.tid, lane = F.lane, r32 = lane & 31, hi = lane >> 5, wid = F.wave;
    LAS unsigned char* Kl = F.lds + RING_OFF; LAS unsigned char* Vl = F.lds + RING_OFF + 32768;
    LAS float* wsf = (LAS float*)(F.lds + RING_OFF + 65536) + wid * 64;
    LAS unsigned short* stg = (LAS unsigned short*)(F.lds + RING_OFF + 65536 + 2048) + wid * 2048;
    const float* qg = F_QNG(F) + layer * 64; const float* kg = F_KNG(F) + layer * 64; const float* sk = F_SINKS(F) + layer * 8;
    const int vlane = (4 * hi + ((lane & 15) >> 2)) * 64 + ((lane >> 4) & 1) * 32 + (lane & 3) * 8;
    float qk_bound;
    { float a = fabsf(qg[lane]), b = fabsf(kg[lane]);
#pragma unroll
      for (int o = 1; o < 64; o <<= 1) { a = fmaxf(a, shx(a, o, lane)); b = fmaxf(b, shx(b, o, lane)); }
      qk_bound = 0.125f * LOG2E * 64.0f * 1.01f * a * b; }
    for (int u = F.vcu; u < BATCH * 32 * 2; u += F.G) {
        const int kvh = u & 1, n = (u >> 1) & 31, b = u >> 6;
        __syncthreads();
        { const int r = tid >> 1, hf = tid & 1; const int tok = (n - 1) * 128 + r;
          float kf[32]; float ss = 0.f; v4u vw[4];
          if (tok >= 0) {
              const bf16* kp = PRW(PROJ, (size_t)(b * SEQ + tok)) + C_AK + kvh * 64 + hf * 32;
              const bf16* vp = PRW(PROJ, (size_t)(b * SEQ + tok)) + C_AV + kvh * 64 + hf * 32;
#pragma unroll
              for (int i = 0; i < 4; ++i) { const v4u w = __builtin_nontemporal_load((const GAS v4u*)(kp + 8 * i)); unpack8(w, kf + 8 * i); vw[i] = __builtin_nontemporal_load((const GAS v4u*)(vp + 8 * i)); }
#pragma unroll
              for (int i = 0; i < 32; ++i) ss += kf[i] * kf[i];
          } else {
#pragma unroll
              for (int i = 0; i < 32; ++i) kf[i] = 0.f;
#pragma unroll
              for (int i = 0; i < 4; ++i) vw[i] = (v4u){0u, 0u, 0u, 0u};
          }
          ss += shx(ss, 1, lane);
          const float rstd = 1.0f / sqrtf(ss * (1.0f / 64.0f) + EPS);
#pragma unroll
          for (int i = 0; i < 4; ++i) { v4u o; const float* gp = kg + hf * 32 + 8 * i;
              o.x = pk2(kf[8 * i] * rstd * gp[0], kf[8 * i + 1] * rstd * gp[1]); o.y = pk2(kf[8 * i + 2] * rstd * gp[2], kf[8 * i + 3] * rstd * gp[3]);
              o.z = pk2(kf[8 * i + 4] * rstd * gp[4], kf[8 * i + 5] * rstd * gp[5]); o.w = pk2(kf[8 * i + 6] * rstd * gp[6], kf[8 * i + 7] * rstd * gp[7]);
              *(LAS v4u*)(Kl + (hf * 4 + i) * 4096 + r * 16) = o;
              *(LAS v4u*)(Vl + hf * 16384 + (r >> 4) * 1024 + (r & 15) * 64 + i * 16) = vw[i]; }
        }
        __syncthreads();
        const int h = kvh * 4 + (wid >> 1);
        const float slope2 = ldexpf(LOG2E, -(h + 1)), sink2 = sk[h] * LOG2E;
        const float mref = fmaxf(qk_bound, sink2);
#pragma unroll 1
        for (int qt = 0; qt < 2; ++qt) {
            const int q0 = (wid & 1) * 64 + qt * 32, j0 = q0 >> 5;
            const size_t row = (size_t)b * SEQ + n * 128 + q0 + r32;
            bf16x8 qr[4];
            { float qf[32]; float ss = 0.f; const bf16* qp = PRW(PROJ, row) + C_AQ + h * 64 + 8 * hi;
#pragma unroll
              for (int d0 = 0; d0 < 4; ++d0) { const v4u w = __builtin_nontemporal_load((const GAS v4u*)(qp + 16 * d0)); unpack8(w, qf + 8 * d0); }
#pragma unroll
              for (int i = 0; i < 32; ++i) ss += qf[i] * qf[i];
              ss += shx(ss, 32, lane);
              const float sc = (1.0f / sqrtf(ss * (1.0f / 64.0f) + EPS)) * (0.125f * LOG2E);
#pragma unroll
              for (int d0 = 0; d0 < 4; ++d0) { const float* gp = qg + 16 * d0 + 8 * hi; v4u o;
                  o.x = pk2(qf[8 * d0] * sc * gp[0], qf[8 * d0 + 1] * sc * gp[1]); o.y = pk2(qf[8 * d0 + 2] * sc * gp[2], qf[8 * d0 + 3] * sc * gp[3]);
                  o.z = pk2(qf[8 * d0 + 4] * sc * gp[4], qf[8 * d0 + 5] * sc * gp[5]); o.w = pk2(qf[8 * d0 + 6] * sc * gp[6], qf[8 * d0 + 7] * sc * gp[7]);
                  qr[d0] = __builtin_bit_cast(bf16x8, o); } }
            int r32m = r32, him = hi; asm volatile("" : "+v"(r32m), "+v"(him));
            const float cinit = -slope2 * (float)(128 + r32m - 4 * him) - mref;
            f32x16 cv;
#pragma unroll
            for (int r = 0; r < 16; ++r) cv[r] = cinit;
            f32x16 p[5];
#pragma unroll
            for (int i = 0; i < 5; ++i) { f32x16 acc = cv;
#pragma unroll
                for (int d0 = 0; d0 < 4; ++d0) { const bf16x8 kfr = *(const LAS bf16x8*)(Kl + (2 * d0 + hi) * 4096 + (32 * (j0 + i) + r32) * 16); acc = MFMA32(kfr, qr[d0], acc); }
                p[i] = acc; }
            float l = 0.f;
#pragma unroll
            for (int i = 0; i < 5; ++i) { const bool tile_ok = (n > 0) || (j0 + i >= 4);
#pragma unroll
                for (int r = 0; r < 16; ++r) { const int cr = (r & 3) + 8 * (r >> 2);
                    float e = __builtin_amdgcn_exp2f(__builtin_fmaf(slope2, (float)(32 * i + cr), p[i][r]));
                    bool ok = tile_ok; if (i == 0) ok = ok && (cr + 4 * him > r32m); if (i == 4) ok = ok && (cr + 4 * him <= r32m);
                    e = ok ? e : 0.f; p[i][r] = e; l += e; } }
            l += shx(l, 32, lane); l += __builtin_amdgcn_exp2f(sink2 - mref);
            f32x16 o[2]; o[0] = (f32x16){}; o[1] = (f32x16){};
#pragma unroll
            for (int i = 0; i < 5; ++i)
#pragma unroll
                for (int s = 0; s < 2; ++s) { const bf16x8 pa = pack8(p[i], s);
#pragma unroll
                    for (int d0 = 0; d0 < 2; ++d0) { const bf16x8 vf = vfrag(Vl + d0 * 16384 + (2 * (j0 + i) + s) * 1024 + vlane); o[d0] = MFMA32(pa, vf, o[d0]); } }
            if (hi == 0) wsf[r32] = 1.0f / l;
            float rli[16];
#pragma unroll
            for (int r = 0; r < 16; ++r) rli[r] = wsf[crow(r, hi)];
#pragma unroll
            for (int r = 0; r < 16; ++r) { const int orow = crow(r, hi);
#pragma unroll
                for (int d0 = 0; d0 < 2; ++d0) stg[orow * 64 + d0 * 32 + r32] = (unsigned short)f2bf(o[d0][r] * rli[r]); }
            bf16* Ow = MXW(MIX, (size_t)b * SEQ + n * 128 + q0) + h * 64;
#pragma unroll
            for (int i = 0; i < 4; ++i) { const int orow = i * 8 + (lane >> 3), ch = lane & 7; const v4u v = *(const LAS v4u*)(stg + orow * 64 + ch * 8); *(GAS v4u*)(Ow + (size_t)orow * D + ch * 8) = v; }
        }
    }
    __syncthreads();
}

__device__ __forceinline__ void ret_kv_mfma(Frame& F, const bf16* PROJ, float* KVT, unsigned* cnt_kv  , unsigned* ev, unsigned nloc) {
    LAUNDER(F);
    const int tid = F.tid, lane = F.lane, r32 = lane & 31, hi = lane >> 5, wid = F.wave;
    const int vlane = (4 * hi + ((lane & 15) >> 2)) * 64 + ((lane >> 4) & 1) * 32 + (lane & 3) * 8;
    for (int up = F.vcu; up < 256; up += F.G) {
        __syncthreads();
#pragma unroll 1
        for (int U = 0; U < 2; ++U) { const int u = 2 * up + U, h = u & 3; const size_t row0 = (size_t)(u >> 2) * 128;
            const float lg = ret_log_gamma(h);
            const int r = tid >> 2, part = tid & 3;
            const bf16* kp = PRW(PROJ, row0 + r) + C_RK + h * 128 + part * 32;
            const bf16* vp = PRW(PROJ, row0 + r) + C_RV + h * 128 + part * 32;
            const float dk = __expf(lg * (float)(127 - r)) * 0.08838834764831845f;
            LAS unsigned char* kl = F.lds + RING_OFF + U * 65536 + part * 8192 + (r >> 4) * 1024 + (r & 15) * 64;
#pragma unroll
            for (int i = 0; i < 4; ++i) { const v4u w = *(const GAS v4u*)(kp + 8 * i); float f[8]; unpack8(w, f);
                v4u o; o.x = pk2(f[0] * dk, f[1] * dk); o.y = pk2(f[2] * dk, f[3] * dk); o.z = pk2(f[4] * dk, f[5] * dk); o.w = pk2(f[6] * dk, f[7] * dk);
                *(LAS v4u*)(kl + i * 16) = o;
                *(LAS v4u*)(kl + 32768 + i * 16) = *(const GAS v4u*)(vp + 8 * i); }
        }
        __syncthreads();
#pragma unroll 1
        for (int U = 0; U < 2; ++U) { const int u = 2 * up + U;
            const LAS unsigned char* kl = F.lds + RING_OFF + U * 65536; const LAS unsigned char* vl = kl + 32768;
            const int et = wid >> 1, dt0 = 2 * (wid & 1);
            f32x16 a0 = {}, a1 = {};
#pragma unroll
            for (int ks = 0; ks < 8; ++ks) { const bf16x8 av = vfrag(vl + et * 8192 + ks * 1024 + vlane);
                const bf16x8 b0 = vfrag(kl + dt0 * 8192 + ks * 1024 + vlane), b1 = vfrag(kl + (dt0 + 1) * 8192 + ks * 1024 + vlane);
                a0 = MFMA32(av, b0, a0); a1 = MFMA32(av, b1, a1); }
            float* op = KVT + (size_t)u * 16384 + (size_t)(32 * et) * 128 + 32 * dt0 + r32;
#pragma unroll
            for (int r = 0; r < 16; ++r) { const int e = crow(r, hi); op[e * 128] = a0[r]; op[e * 128 + 32] = a1[r]; }
        }
        { const int u0 = 2 * up, bh0 = ((u0 >> 7) << 2) | (u0 & 3);
          mix_publish_xcc(tid, ev, nloc, cnt_kv + 64 * bh0, cnt_kv + 64 * (bh0 + 1)); }
    }
    __syncthreads();
}
__device__ __forceinline__ void ret_out_mfma(Frame& F, int layer, const bf16* PROJ, const bf16* PREVT, bf16* MIX, unsigned* sc0, unsigned* sc1  ) {
    LAUNDER(F);
    const int tid = F.tid, lane = F.lane, r32 = lane & 31, hi = lane >> 5, wid = F.wave;
    const int vlane = (4 * hi + ((lane & 15) >> 2)) * 64 + ((lane >> 4) & 1) * 32 + (lane & 3) * 8;
    const float* gain = F_RNG(F) + layer * 512;
    for (int up = F.vcu; up < 256; up += F.G) {
        __syncthreads();
        const int U = wid >> 2, it = U ? 3 - (wid & 3) : (wid & 3);
        const int u = 2 * up + U, h = u & 3; const size_t row = (size_t)(u >> 2) * 128 + 32 * it + r32;
        bf16x8 qf[8];
        { const bf16* qp = PRW(PROJ, row) + C_RQ + h * 128 + 8 * hi;
#pragma unroll
          for (int ds = 0; ds < 8; ++ds) qf[ds] = __builtin_nontemporal_load((const GAS bf16x8*)(qp + 16 * ds)); }
#pragma unroll 1
        for (int Us = 0; Us < 2; ++Us) { const int us = 2 * up + Us, hs = us & 3; const size_t row0 = (size_t)(us >> 2) * 128;
            const float lg = ret_log_gamma(hs);
            const int r = tid >> 2, part = tid & 3;
            const bf16* kp = PRW(PROJ, row0 + r) + C_RK + hs * 128 + part * 32;
            const bf16* vp = PRW(PROJ, row0 + r) + C_RV + hs * 128 + part * 32;
            const float dk = __expf(lg * (float)(127 - r)) * 0.08838834764831845f;
            LAS unsigned char* kl = F.lds + RING_OFF + Us * 65536 + (part * 4) * 2048 + r * 16;
            LAS unsigned char* vl = F.lds + RING_OFF + Us * 65536 + 32768 + part * 8192 + (r >> 4) * 1024 + (r & 15) * 64;
#pragma unroll
            for (int i = 0; i < 4; ++i) { const v4u w = __builtin_nontemporal_load((const GAS v4u*)(kp + 8 * i)); float f[8]; unpack8(w, f);
                v4u o; o.x = pk2(f[0] * dk, f[1] * dk); o.y = pk2(f[2] * dk, f[3] * dk); o.z = pk2(f[4] * dk, f[5] * dk); o.w = pk2(f[6] * dk, f[7] * dk);
                *(LAS v4u*)(kl + i * 2048) = o;
                *(LAS v4u*)(vl + i * 16) = __builtin_nontemporal_load((const GAS v4u*)(vp + 8 * i)); }
        }
        __syncthreads();
        const LAS unsigned char* kl = F.lds + RING_OFF + U * 65536; const LAS unsigned char* vl = kl + 32768;
        f32x16 acc[4];
#pragma unroll
        for (int et = 0; et < 4; ++et) acc[et] = (f32x16){};
#pragma unroll 1
        for (int jt = 0; jt <= it; ++jt) {
            f32x16 S = {};
#pragma unroll
            for (int ds = 0; ds < 8; ++ds) { const bf16x8 kfr = *(const LAS bf16x8*)(kl + (2 * ds + hi) * 2048 + (32 * jt + r32) * 16); S = MFMA32(kfr, qf[ds], S); }
            if (jt == it) {
#pragma unroll
                for (int r = 0; r < 16; ++r) S[r] = (crow(r, hi) <= r32) ? S[r] : 0.f; }
            const bf16x8 pb0 = pack8(S, 0), pb1 = pack8(S, 1);
#pragma unroll
            for (int et = 0; et < 4; ++et) { const bf16x8 v0 = vfrag(vl + et * 8192 + (2 * jt) * 1024 + vlane), v1 = vfrag(vl + et * 8192 + (2 * jt + 1) * 1024 + vlane);
                acc[et] = MFMA32(v0, pb0, acc[et]); acc[et] = MFMA32(v1, pb1, acc[et]); }
        }
        mix_wait(wid, sc0, 16u, sc1, 16u);
        { const bf16* pp = PREVT + (size_t)u * 16384 + (size_t)r32 * 128 + 8 * hi;
#pragma unroll
          for (int ds = 0; ds < 8; ++ds)
#pragma unroll
              for (int et = 0; et < 4; ++et) { const bf16x8 pa = *(const GAS bf16x8*)(pp + (size_t)(32 * et) * 128 + 16 * ds); acc[et] = MFMA32(pa, qf[ds], acc[et]); } }
        const float dq = __expf(ret_log_gamma(h) * (float)(32 * it + r32 - 127));
        float s1 = 0.f;
#pragma unroll
        for (int et = 0; et < 4; ++et)
#pragma unroll
            for (int r = 0; r < 16; ++r) { acc[et][r] *= dq; s1 += acc[et][r]; }
        s1 += shx(s1, 32, lane);
        const float mu = s1 * (1.0f / 128.0f);
        float s2 = 0.f;
#pragma unroll
        for (int et = 0; et < 4; ++et)
#pragma unroll
            for (int r = 0; r < 16; ++r) { acc[et][r] -= mu; s2 += acc[et][r] * acc[et][r]; }
        s2 += shx(s2, 32, lane);
        const float rstd = 1.0f / sqrtf(s2 * (1.0f / 128.0f) + EPS);
        { LAS unsigned char* stg = F.lds + RSTG_OFF + wid * 2560;
          const size_t rowb = (size_t)(u >> 2) * 128 + 32 * it;
          const int orow = lane >> 2, oc = lane & 3;
          v4u gw[4][2];
#pragma unroll
          for (int et = 0; et < 4; ++et)
#pragma unroll
              for (int j = 0; j < 2; ++j) gw[et][j] = __builtin_nontemporal_load((const GAS v4u*)(PRW(PROJ, rowb + 16 * j + orow) + C_RG + h * 128 + 32 * et + 8 * oc));
#pragma unroll
          for (int et = 0; et < 4; ++et) {
#pragma unroll
              for (int rg = 0; rg < 4; ++rg) { typedef unsigned u32x2 __attribute__((ext_vector_type(2))); u32x2 w;
                  w.x = cvtpk(acc[et][4 * rg] * rstd, acc[et][4 * rg + 1] * rstd); w.y = cvtpk(acc[et][4 * rg + 2] * rstd, acc[et][4 * rg + 3] * rstd);
                  *(LAS u32x2*)(stg + r32 * 80 + (8 * rg + 4 * hi) * 2) = w; }
#pragma unroll
              for (int j = 0; j < 2; ++j) { const v4u yw = *(const LAS v4u*)(stg + (16 * j + orow) * 80 + oc * 16);
                  float y[8], g[8]; unpack8(yw, y); unpack8(gw[et][j], g);
                  const float* gn = gain + h * 128 + 32 * et + 8 * oc; const f32x4 g0 = *(const f32x4*)gn, g1 = *(const f32x4*)(gn + 4);
                  const float gv[8] = {g0.x, g0.y, g0.z, g0.w, g1.x, g1.y, g1.z, g1.w};
                  float o[8];
#pragma unroll
                  for (int e = 0; e < 8; ++e) o[e] = (g[e] * __builtin_amdgcn_rcpf(1.0f + __builtin_amdgcn_exp2f(-LOG2E * g[e]))) * y[e] * gv[e];
                  v4u ow; ow.x = pk2(o[0], o[1]); ow.y = pk2(o[2], o[3]); ow.z = pk2(o[4], o[5]); ow.w = pk2(o[6], o[7]);
                  *(GAS v4u*)(MXW(MIX, rowb + 16 * j + orow) + 512 + h * 128 + 32 * et + 8 * oc) = ow; }
          }
        }
    }
    __syncthreads();
}
#ifndef CHAOS
#define CHAOS 0
#endif
#define CHAOS_DELAY(which, cond) do { if (CHAOS == (which) && (cond)) { const unsigned long long t0_ = __builtin_amdgcn_s_memrealtime(); while (__builtin_amdgcn_s_memrealtime() - t0_ < 10000ull) __builtin_amdgcn_s_sleep(32); } } while (0)
__global__ void __launch_bounds__(NWAVES * 64, 2) fwd(Args args_unused_directly) {
    extern __shared__ __attribute__((aligned(16))) unsigned char lds[];
    Frame F;
    F.lds = (LAS unsigned char*)lds;
    F.wave0 = __builtin_amdgcn_readfirstlane((int)threadIdx.x >> 6);
    F.G0 = gridDim.x; { const int bx = blockIdx.x; F.vcu0 = (F.G0 % 8 == 0) ? (bx % 8) * (F.G0 / 8) + bx / 8 : bx; }
    LAUNDER(F);
    volatile LAS unsigned* MISC = (volatile LAS unsigned*)(F.lds + MISC_OFF);
    for (int u = F.tid; u < (LDS_BYTES - LDSCTL_OFF) / 4; u += NWAVES * 64) ((LAS unsigned*)(F.lds + LDSCTL_OFF))[u] = 0u;
    __syncthreads();
    XcdBarrier bar = xcd_barrier_post((unsigned*)(F_WS(F) + WS_CTL) + CW_BAR, MISC + 8, F.tid);
    if (F.tid == 0) __hip_atomic_store((unsigned*)(F_WS(F) + WS_CTL) + CW_XCC + F.vcu0, (unsigned)(__builtin_amdgcn_s_getreg((3 << 11) | 20) & 0xFu) + 1u, __ATOMIC_RELAXED, __HIP_MEMORY_SCOPE_AGENT);
#define GRID_BAR() do { LAUNDER(F); bar.bar = (unsigned*)(F_WS(F) + WS_CTL) + CW_BAR; { unsigned x_; asm volatile("s_getreg_b32 %0, hwreg(HW_REG_XCC_ID, 0, 4)" : "=s"(x_)); bar.x = x_ & 0xFu; } xcd_barrier(bar, F.tid); } while (0)
#define WSP(off) (get_args()->ws + (off))
#define TEAM_T (F.vcu >> 2)
#define TEAM_Q (F.vcu & 3)
#define TEAM_CNT(l_, t_) ((unsigned*)(F_WS(F) + WS_CTL) + CW_TEAM + ((l_) * 64 + (t_)) * 64)
#define TEAM_XCC(t_) ({ const unsigned* xt_ = (const unsigned*)(F_WS(F) + WS_CTL) + CW_XCC + 4 * (t_); const unsigned a_ = __hip_atomic_load(xt_, __ATOMIC_RELAXED, __HIP_MEMORY_SCOPE_AGENT), b_ = __hip_atomic_load(xt_ + 1, __ATOMIC_RELAXED, __HIP_MEMORY_SCOPE_AGENT), \
        c_ = __hip_atomic_load(xt_ + 2, __ATOMIC_RELAXED, __HIP_MEMORY_SCOPE_AGENT), d_ = __hip_atomic_load(xt_ + 3, __ATOMIC_RELAXED, __HIP_MEMORY_SCOPE_AGENT); (unsigned)__builtin_amdgcn_readfirstlane((int)((a_ == b_ && a_ == c_ && a_ == d_) ? a_ : 0u)); })
#define TEAM_SAME() (TEAM_XCC(TEAM_T) != 0u)
#define TEAM_SAME_NEXT() ({ const unsigned me_ = TEAM_XCC(TEAM_T); const unsigned nx_ = ((TEAM_T & 15) != 15) ? TEAM_XCC(TEAM_T + 1) : me_; (bool)(me_ != 0u && me_ == nx_); })
#define TEAM_SYNC(l_, stage_) do { LAUNDER(F); team_sync(F.tid, F.wave, TEAM_CNT(l_, TEAM_T), 4u * (unsigned)(stage_), TEAM_SAME()); } while (0)
#define TEAM_SYNC_X(l_, stage_) do { LAUNDER(F); team_sync(F.tid, F.wave, TEAM_CNT(l_, TEAM_T), 4u * (unsigned)(stage_), TEAM_SAME_NEXT()); } while (0)
#define TEAM_SYNC_GUARD(l_, stage_, gt_, gstage_) do { LAUNDER(F); team_sync(F.tid, F.wave, TEAM_CNT(l_, TEAM_T), 4u * (unsigned)(stage_), TEAM_SAME(), TEAM_CNT(l_, gt_), 4u * (unsigned)(gstage_)); } while (0)
#define INPROJ(l_) do { LAUNDER(F); const bf16* wl = (const bf16*)(F_WS(F) + WS_W + (size_t)(l_) * W_LAYER); \
        pg8::Gemm g{(const bf16*)(F_WS(F) + WS_XN), wl + WO_IN / 2, M, NIN, D, 256u * D * 2u}; pg8::TeamOrder S{TEAM_T, 3 * TEAM_Q, (TEAM_Q == 3) ? 2 : 3}; \
        if ((l_) == 0) { pg8::EpiBf16<0, 0> E{(bf16*)(F_WS(F) + WS_PROJ), NIN, nullptr, nullptr, 0, SEQ, 0.f, 0.f, (unsigned)PANEL_ELEMS}; \
            pg8::gemm_phase<pg8::EpiBf16<0, 0>, pg8::TeamOrder, PG8_ALIGN, PG8_SP2>(F.lds + RING_OFF, g, S, E, F.wave); \
            if (TEAM_Q == 3) { sw_phase(F, TEAM_T, 64); LAUNDER(F); mix_publish(F.tid, (unsigned*)(F_WS(F) + WS_CTL) + CW_SWCNT, nullptr); } } \
        else { pg8::EpiBf16<0, 1> E{(bf16*)(F_WS(F) + WS_PROJ), NIN, (const float*)(F_WS(F) + WS_SSQ) + 1 * M, (const float*)(F_WS(F) + WS_SW) + 1 * BATCH * 4096, 4096, SEQ, 1.0f / D, EPS, (unsigned)PANEL_ELEMS}; \
            pg8::gemm_phase<pg8::EpiBf16<0, 1>, pg8::TeamOrder, PG8_ALIGN, PG8_SP2>(F.lds + RING_OFF, g, S, E, F.wave); } } while (0)

    p0a_phase(F); p0b_items(F); GRID_BAR();
    CHAOS_DELAY(1, (F.vcu0 >> 2) & 1);
    { LAUNDER(F); const float* ada_0 = F_ADA(F);
      xn_phase(F, F_X(F), F_N1G(F), ada_0 + 0 * D, ada_0 + 1 * D, (bf16*)(F_WS(F) + WS_XN));
      TEAM_SYNC(NLAYER, 1); INPROJ(0); TEAM_SYNC_X(NLAYER, 2); }
#pragma unroll 1
    for (int l = 0; l < NLAYER; ++l) {
        {
            unsigned* cnt_kv = (unsigned*)(get_args()->ws + WS_CTL) + CW_MIX + (l * 2 + 0) * 1024;
#define XEV(l_, e_) ((unsigned*)(get_args()->ws + WS_CTL) + CW_XEV + ((((l_) * 2 + (e_)) * 16 + (int)((unsigned)__builtin_amdgcn_s_getreg((3 << 11) | 20) & 0xFu)) * 128))
            ret_kv_mfma(F, (const bf16*)WSP(WS_PROJ), (float*)WSP(WS_KV), cnt_kv, XEV(l, 0), MISC[8]);
            { LAUNDER(F);
              if (TEAM_Q < 2 && (TEAM_T & 15) != 0) mix_wait(F.wave, TEAM_CNT((l == 0) ? NLAYER : l - 1, TEAM_T - 1), (l == 0) ? 8u : 20u, nullptr, 0u); }
            CHAOS_DELAY(2, ((F.vcu0 >> 2) & 1) == 0); CHAOS_DELAY(5, (F.vcu0 & 3) == 2);
            attn_mfma(F, l, (const bf16*)WSP(WS_PROJ), (bf16*)WSP(WS_MIX));
            { LAUNDER(F); cnt_kv = (unsigned*)(F_WS(F) + WS_CTL) + CW_MIX + (l * 2 + 0) * 1024;
              const int bh = F.vcu >> 4; mix_wait(F.wave, cnt_kv + 64 * bh, 32u, nullptr, 0u);
              ret_scan(F, (const float*)WSP(WS_KV), (bf16*)WSP(WS_PREV));
              LAUNDER(F); mix_publish_xcc(F.tid, XEV(l, 1), MISC[8], (unsigned*)(F_WS(F) + WS_CTL) + CW_MIX + (l * 2 + 1) * 1024 + 64 * (F.vcu >> 4), nullptr); }
            { const int u0 = 2 * F.vcu0, bh0 = ((u0 >> 7) << 2) | (u0 & 3); unsigned* cs = (unsigned*)(get_args()->ws + WS_CTL) + CW_MIX + (l * 2 + 1) * 1024;
              ret_out_mfma(F, l, (const bf16*)WSP(WS_PROJ), (const bf16*)WSP(WS_PREV), (bf16*)WSP(WS_MIX), cs + 64 * bh0, cs + 64 * (bh0 + 1)); }
            TEAM_SYNC(l, 1);
        }
        {
            { LAUNDER(F); const bf16* wl = (const bf16*)(F_WS(F) + WS_W + (size_t)l * W_LAYER); const float* ada_l = F_ADA(F) + (size_t)l * BATCH * ADA;
              pg8::Gemm g{(const bf16*)(F_WS(F) + WS_MIX), wl + WO_OUT / 2, M, D, D, (unsigned)(PANEL_ELEMS * 2)}; pg8::TeamOrder S{TEAM_T, TEAM_Q, 1};
              if (l == 0) { pg8::EpiResGate<1, 0, 1> E{F_X(F), F_OUT(F), D, ada_l + 2 * D, ADA, SEQ, (bf16*)(F_WS(F) + WS_XN), F_N2G(F) + l * D, ada_l + 4 * D, (float*)(F_WS(F) + WS_SSQ) + (size_t)(2 * l) * M, 256u * D, 524288u};
                  pg8::gemm_phase<pg8::EpiResGate<1, 0, 1>, pg8::TeamOrder, PG8_ALIGN, PG8_SP2>(F.lds + RING_OFF, g, S, E, F.wave); }
              else { pg8::EpiResGate<1, 1, 1> E{F_OUT(F), F_WS(F) + WS_KV, D, ada_l + 2 * D, ADA, SEQ, (bf16*)(F_WS(F) + WS_XN), F_N2G(F) + l * D, ada_l + 4 * D, (float*)(F_WS(F) + WS_SSQ) + (size_t)(2 * l) * M, 524288u, 256u * D};
                  pg8::gemm_phase<pg8::EpiResGate<1, 1, 1>, pg8::TeamOrder, PG8_ALIGN, PG8_SP2>(F.lds + RING_OFF, g, S, E, F.wave); } }
            CHAOS_DELAY(3, (F.vcu0 >> 2) & 1);
            if ((TEAM_T & 15) != 15) TEAM_SYNC_GUARD(l, 2, TEAM_T + 1, 1); else TEAM_SYNC(l, 2);
            CHAOS_DELAY(4, ((F.vcu0 >> 2) % 3) == 0);
            if (l == 0) { LAUNDER(F); mix_wait(F.wave, (unsigned*)(F_WS(F) + WS_CTL) + CW_SWCNT, 64u, nullptr, 0u); }
            { LAUNDER(F); const bf16* wl = (const bf16*)(F_WS(F) + WS_W + (size_t)l * W_LAYER);
              pg8::Gemm g{(const bf16*)(F_WS(F) + WS_XN), wl + WO_1 / 2, M, FF, D, 256u * D * 2u}; pg8::TeamOrder S{TEAM_T, 4 * TEAM_Q, 4};
              pg8::EpiBf16<1, 1> E{(bf16*)(F_WS(F) + WS_H), FF, (const float*)(F_WS(F) + WS_SSQ) + (size_t)(2 * l) * M, (const float*)(F_WS(F) + WS_SW) + (size_t)(2 * l) * BATCH * 4096, 4096, SEQ, 1.0f / D, EPS, 256u * FF};
              pg8::gemm_phase<pg8::EpiBf16<1, 1>, pg8::TeamOrder, PG8_ALIGN, PG8_SP2>(F.lds + RING_OFF, g, S, E, F.wave); }
            TEAM_SYNC(l, 3);
            { LAUNDER(F); const bf16* wl = (const bf16*)(F_WS(F) + WS_W + (size_t)l * W_LAYER); const float* ada_l = F_ADA(F) + (size_t)l * BATCH * ADA;
              pg8::Gemm g{(const bf16*)(F_WS(F) + WS_H), wl + WO_2 / 2, M, D, FF, 256u * FF * 2u}; pg8::TeamOrder S{TEAM_T, TEAM_Q, 1};
              if (l + 1 < NLAYER) { const float* ada_n = ada_l + (size_t)BATCH * ADA;
                  pg8::EpiResGate<1, 1, 1> E{F_OUT(F), F_OUT(F), D, ada_l + 5 * D, ADA, SEQ, (bf16*)(F_WS(F) + WS_XN), F_N1G(F) + (l + 1) * D, ada_n + 1 * D, (float*)(F_WS(F) + WS_SSQ) + (size_t)(2 * l + 1) * M, 524288u, 524288u};
                  pg8::gemm_phase<pg8::EpiResGate<1, 1, 1>, pg8::TeamOrder, PG8_ALIGN, PG8_SP2>(F.lds + RING_OFF, g, S, E, F.wave); }
              else { pg8::EpiResGate<0, 1, 0> E{F_WS(F) + WS_KV, F_OUT(F), D, ada_l + 5 * D, ADA, SEQ, nullptr, nullptr, nullptr, nullptr, 256u * D, 256u * D};
                  pg8::gemm_phase<pg8::EpiResGate<0, 1, 0>, pg8::TeamOrder, PG8_ALIGN, PG8_SP2>(F.lds + RING_OFF, g, S, E, F.wave); } }
            CHAOS_DELAY(6, ((F.vcu0 >> 2) & 3) == 1);
            if (l + 1 < NLAYER) { TEAM_SYNC(l, 4); INPROJ(l + 1); TEAM_SYNC_X(l, 5); }
        }
    }
}

extern "C" void kernel_launch(void* const* d_in, const int* in_sizes, int n_in, void* d_out, int out_size, void* d_ws, size_t ws_size, hipStream_t stream) {
    static int grid = 0;
    if (grid == 0) {
        if (n_in != 14 || in_sizes[0] != M * D || out_size != M * D || ws_size < WS_END) { fprintf(stderr, "kernel_launch: unexpected shapes (n_in %d, in0 %d, out %d, ws %zu); nothing launched\n", n_in, n_in > 0 ? in_sizes[0] : -1, out_size, ws_size); grid = -1; return; }
        int dev = 0, cus = 0, per_cu = 0;
        if (hipGetDevice(&dev) != hipSuccess || hipDeviceGetAttribute(&cus, hipDeviceAttributeMultiprocessorCount, dev) != hipSuccess) { grid = -1; return; }
        if (hipFuncSetAttribute((const void*)fwd, hipFuncAttributeMaxDynamicSharedMemorySize, LDS_BYTES) != hipSuccess) { fprintf(stderr, "kernel_launch: hipFuncSetAttribute failed\n"); grid = -1; return; }
        if (hipOccupancyMaxActiveBlocksPerMultiprocessor(&per_cu, (const void*)fwd, NWAVES * 64, LDS_BYTES) != hipSuccess || per_cu < 1) { fprintf(stderr, "kernel_launch: occupancy query reports %d blocks per CU\n", per_cu); }
        (void)hipGetLastError();
        grid = cus;
        if (cus != 256) { fprintf(stderr, "kernel_launch: built for a 256-CU device (work maps are static per workgroup); this device reports %d CUs; nothing launched\n", cus); grid = -1; return; }
    }
    if (grid < 0) return;
    if (hipMemsetAsync((char*)d_ws + WS_CTL, 0, CTL_ZERO_BYTES, stream) != hipSuccess) { fprintf(stderr, "kernel_launch: hipMemsetAsync failed\n"); return; }
    Args a{};
    for (int i = 0; i < 14; ++i) a.in[i] = (const float*)d_in[i];
    a.out = (float*)d_out; a.ws = (unsigned char*)d_ws;
    hipLaunchKernelGGL(fwd, dim3(grid), dim3(NWAVES * 64), LDS_BYTES, stream, a);
    const hipError_t le = hipPeekAtLastError();
    if (le != hipSuccess) fprintf(stderr, "kernel_launch: launch failed: %s\n", hipGetErrorName(le));
}
```

```cpp
#include <hip/hip_runtime.h>
#include <cstdio>
#include <cstdint>
namespace pg8 {
#define PG8_LAS __attribute__((address_space(3)))
typedef unsigned short bf16_t;
typedef short bf16x8 __attribute__((ext_vector_type(8)));
typedef float f32x4 __attribute__((ext_vector_type(4)));
typedef unsigned u32x4 __attribute__((ext_vector_type(4)));
constexpr int BM = 256, BK = 64, HALF = 128, HTB = HALF * BK * 2  , STAGE_BYTES = 8 * HTB, NXCD = 8, WGM = 8;

__host__ __device__ __forceinline__ int lds_byte(int r, int c) { const int st = (r >> 4) * 2 + (c >> 5), rr = r & 15, cc = c & 31, ob = rr * 64 + cc * 2; return st * 1024 + (ob ^ (((ob >> 9) & 1) << 5)); }
__host__ __device__ __forceinline__ void stage_rc(int b, int& R, int& C) { const int st = b / 1024, sb = b % 1024, swz = sb ^ (((sb >> 9) & 1) << 5); R = (st >> 1) * 16 + swz / 64; C = (st & 1) * 32 + (swz % 64) / 2; }
__host__ __device__ __forceinline__ int perm32(int rho) { const int n = rho >> 4, i = rho & 15; return 8 * (i >> 2) + 4 * n + (i & 3); }

struct Unit { int pm, pn; };
struct Gemm { const bf16_t* A; const bf16_t* Bt; int M, N, K; unsigned a_panel_bytes; };

struct StaticOrder {
    int nM, nN, nwg, G, c;
    __host__ __device__ void init(int M, int N, int G_, int c_) { nM = M / BM; nN = N / BM; nwg = nM * nN; G = G_; c = c_; }
    __host__ __device__ bool next(int i, Unit& u) const {
        const long L = (long)i * G + c; if (L >= nwg) return false;
        int wgid = (int)L; { const int q = nwg / NXCD, r = nwg % NXCD, xcd = wgid % NXCD, off = wgid / NXCD; wgid = (xcd < r ? xcd * (q + 1) : r * (q + 1) + (xcd - r) * q) + off; }
        const int nig = WGM * nN, gid = wgid / nig, fm = gid * WGM, gsz = (nM - fm) < WGM ? (nM - fm) : WGM;
        u.pm = fm + ((wgid % nig) % gsz); u.pn = (wgid % nig) / gsz; return true;
    }
    __device__ __forceinline__ void a_ready(const Unit&) const {}
    __device__ __forceinline__ void done(const Unit&) const {}
};


struct TeamOrder {
    int pm, pn0, cnt;
    __device__ __forceinline__ bool next(int i, Unit& u) const { if (i >= cnt) return false; u.pm = pm; u.pn = pn0 + i; return true; }
    __device__ __forceinline__ void a_ready(const Unit&) const {}
    __device__ __forceinline__ void done(const Unit&) const {}
};
__device__ __forceinline__ unsigned cvt_pk_bf16(float lo, float hi) { unsigned r; asm volatile("v_cvt_pk_bf16_f32 %0, %1, %2" : "=v"(r) : "v"(lo), "v"(hi)); return r; }

constexpr float ADA_FX = 16777216.0f, ADA_IFX = 1.0f / 16777216.0f, SSQ_FX = 4096.0f, SSQ_IFX = 1.0f / 4096.0f;
typedef int i32x4 __attribute__((ext_vector_type(4)));
__device__ __forceinline__ f32x4 ld_ada4(const float* p) { const i32x4 v = *(const i32x4*)p; return (f32x4){(float)v.x, (float)v.y, (float)v.z, (float)v.w} * ADA_IFX; }
typedef unsigned u32x2_t __attribute__((ext_vector_type(2)));
#ifndef PG8_ST_AUX
#define PG8_ST_AUX 0
#endif
#ifndef PG8_RES_AUX
#define PG8_RES_AUX 0
#endif
#define PG8_RSRC(p) __builtin_amdgcn_make_buffer_rsrc((void*)(p), 0, 0x7ffffff0, 0x00020000)
__device__ __forceinline__ void st16_wt(__amdgpu_buffer_rsrc_t r, unsigned byte_off, u32x4 v) { __builtin_amdgcn_raw_buffer_store_b128(v, r, byte_off, 0, PG8_ST_AUX); }
__device__ __forceinline__ void st8_wt(__amdgpu_buffer_rsrc_t r, unsigned byte_off, u32x2_t v) { __builtin_amdgcn_raw_buffer_store_b64(v, r, byte_off, 0, PG8_ST_AUX); }
template <int ACT  , int NORM> struct EpiBf16 {
    static constexpr bool PERM = true, AFTER_DRAIN = false;
    bf16_t* O; int ldc; const float* ssq; const float* sw; int sw_bstride; int rows_per_batch; float inv_n, eps; unsigned o_panel_elems;
    __device__ __forceinline__ void operator()(const f32x4 (&acc)[2][2][4][2], const Unit& u, int wr, int wc, int fr_in, int fq_in) const {
        int fr = fr_in, fq = fq_in; asm volatile("" : "+v"(fr), "+v"(fq));
        const int row0 = u.pm * BM + wr * 64 + fr; const int col0 = u.pn * BM + wc * 32 + 8 * fq;
        const __amdgpu_buffer_rsrc_t rO = PG8_RSRC(O);
        f32x4 sv[2][2];
        if (NORM) { const float* sp = sw + (size_t)((u.pm * BM) / rows_per_batch) * sw_bstride + col0;
#pragma unroll
            for (int bj = 0; bj < 2; ++bj) { sv[bj][0] = *(const f32x4*)(sp + bj * HALF); sv[bj][1] = *(const f32x4*)(sp + bj * HALF + 4); } }
#pragma unroll
        for (int ai = 0; ai < 2; ++ai)
#pragma unroll
            for (int m = 0; m < 4; ++m) { const int row = row0 + ai * HALF + m * 16; const unsigned rowb = ((unsigned)u.pm * o_panel_elems + (unsigned)(row - u.pm * BM) * (unsigned)ldc + (unsigned)col0) * 2u;
                float rs = 1.f; if (NORM) rs = __builtin_amdgcn_rsqf((float)((const int*)ssq)[row] * (inv_n * SSQ_IFX) + eps);
#pragma unroll
                for (int bj = 0; bj < 2; ++bj) { f32x4 v0 = acc[ai][bj][m][0], v1 = acc[ai][bj][m][1];
                    if (NORM) { v0 = v0 * rs + sv[bj][0]; v1 = v1 * rs + sv[bj][1]; }
                    if (ACT == 1) {
#pragma unroll
                        for (int e = 0; e < 4; ++e) { const float a = fmaxf(v0[e], 0.f), b = fmaxf(v1[e], 0.f); v0[e] = a * a; v1[e] = b * b; } }
                    u32x4 w; w.x = cvt_pk_bf16(v0[0], v0[1]); w.y = cvt_pk_bf16(v0[2], v0[3]); w.z = cvt_pk_bf16(v1[0], v1[1]); w.w = cvt_pk_bf16(v1[2], v1[3]);
                    st16_wt(rO, rowb + bj * HALF * 2, w); } }
    }
};
template <int XG, int BIN, int BOUT> struct EpiResGate {
    static constexpr bool PERM = true, AFTER_DRAIN = false;
    const void* base; void* out; int ldc; const float* gate; int gate_bstride; int rows_per_batch;
    bf16_t* xg; const float* ng; const float* scale; float* ssq; unsigned base_panel, out_panel;
    __device__ __forceinline__ void operator()(const f32x4 (&acc)[2][2][4][2], const Unit& u, int wr, int wc, int fr_in, int fq_in) const {
        int fr = fr_in, fq = fq_in; asm volatile("" : "+v"(fr), "+v"(fq));
        const int row0 = u.pm * BM + wr * 64 + fr, col0 = u.pn * BM + wc * 32 + 8 * fq, lane = fr + 16 * fq;
        const int b = (u.pm * BM) / rows_per_batch;
        const __amdgpu_buffer_rsrc_t rOut = PG8_RSRC(out), rXg = PG8_RSRC(xg);
        const float* gp = gate + (size_t)b * gate_bstride + col0;
        f32x4 gv[2][2], gm[2][2];
#pragma unroll
        for (int bj = 0; bj < 2; ++bj)
#pragma unroll
            for (int n = 0; n < 2; ++n) { gv[bj][n] = ld_ada4(gp + bj * HALF + n * 4);
                if (XG) gm[bj][n] = *(const f32x4*)(ng + col0 + bj * HALF + n * 4) * (ld_ada4(scale + (size_t)b * gate_bstride + col0 + bj * HALF + n * 4) + 1.0f); }
        float ssr[2][4];
        constexpr int RB = BIN ? 4 : 2;
#pragma unroll
        for (int r0 = 0; r0 < 8; r0 += RB) {
            u32x4 bw[RB][2][BIN ? 1 : 2];
#pragma unroll
            for (int r = 0; r < RB; ++r) { const int ai = (r0 + r) >> 2, m = (r0 + r) & 3; const int row = row0 + ai * HALF + m * 16;
                const size_t offb = (size_t)u.pm * base_panel + (size_t)(row - u.pm * BM) * ldc + col0;
#pragma unroll
                for (int bj = 0; bj < 2; ++bj) {
                    if (BIN) bw[r][bj][0] = __builtin_nontemporal_load((const u32x4*)((const bf16_t*)base + offb + bj * HALF));
                    else { bw[r][bj][0] = __builtin_nontemporal_load((const u32x4*)((const float*)base + offb + bj * HALF)); bw[r][bj][BIN ? 0 : 1] = __builtin_nontemporal_load((const u32x4*)((const float*)base + offb + bj * HALF + 4)); } } }
            __builtin_amdgcn_sched_barrier(0);
#pragma unroll
            for (int r = 0; r < RB; ++r) { const int ai = (r0 + r) >> 2, m = (r0 + r) & 3; const int row = row0 + ai * HALF + m * 16; const size_t off = (size_t)row * ldc + col0; float ss = 0.f;
                const size_t offo = (size_t)u.pm * out_panel + (size_t)(row - u.pm * BM) * ldc + col0;
#pragma unroll
                for (int bj = 0; bj < 2; ++bj) { f32x4 b0, b1;
                    if (BIN) { const u32x4 w = bw[r][bj][0];
                        b0 = (f32x4){__uint_as_float(w.x << 16), __uint_as_float(w.x & 0xffff0000u), __uint_as_float(w.y << 16), __uint_as_float(w.y & 0xffff0000u)};
                        b1 = (f32x4){__uint_as_float(w.z << 16), __uint_as_float(w.z & 0xffff0000u), __uint_as_float(w.w << 16), __uint_as_float(w.w & 0xffff0000u)}; }
                    else { b0 = __builtin_bit_cast(f32x4, bw[r][bj][0]); b1 = __builtin_bit_cast(f32x4, bw[r][bj][BIN ? 0 : 1]); }
                    const f32x4 o0 = b0 + gv[bj][0] * acc[ai][bj][m][0], o1 = b1 + gv[bj][1] * acc[ai][bj][m][1];
                    if (BOUT) { u32x4 w; w.x = cvt_pk_bf16(o0[0], o0[1]); w.y = cvt_pk_bf16(o0[2], o0[3]); w.z = cvt_pk_bf16(o1[0], o1[1]); w.w = cvt_pk_bf16(o1[2], o1[3]); __builtin_amdgcn_raw_buffer_store_b128(w, rOut, (unsigned)(offo + bj * HALF) * 2u, 0, PG8_RES_AUX); }
                    else { __builtin_amdgcn_raw_buffer_store_b128(__builtin_bit_cast(u32x4, o0), rOut, (unsigned)(offo + bj * HALF) * 4u, 0, 2); __builtin_amdgcn_raw_buffer_store_b128(__builtin_bit_cast(u32x4, o1), rOut, (unsigned)(offo + bj * HALF + 4) * 4u, 0, 2); }
                    if (XG) { ss += ((o0[0] * o0[0] + o0[1] * o0[1]) + (o0[2] * o0[2] + o0[3] * o0[3])) + ((o1[0] * o1[0] + o1[1] * o1[1]) + (o1[2] * o1[2] + o1[3] * o1[3]));
                        const f32x4 g0 = o0 * gm[bj][0], g1 = o1 * gm[bj][1];
                        u32x4 w; w.x = cvt_pk_bf16(g0[0], g0[1]); w.y = cvt_pk_bf16(g0[2], g0[3]); w.z = cvt_pk_bf16(g1[0], g1[1]); w.w = cvt_pk_bf16(g1[2], g1[3]);
                        st16_wt(rXg, (unsigned)(off + bj * HALF) * 2u, w); } }
                ssr[ai][m] = ss; }
            __builtin_amdgcn_sched_barrier(0);
        }
        if (XG) {
#pragma unroll
            for (int ai = 0; ai < 2; ++ai)
#pragma unroll
                for (int m = 0; m < 4; ++m) { float ss = ssr[ai][m];
                    ss += __int_as_float(__builtin_amdgcn_ds_bpermute((lane ^ 16) << 2, __float_as_int(ss))); ss += __int_as_float(__builtin_amdgcn_ds_bpermute((lane ^ 32) << 2, __float_as_int(ss))); ssr[ai][m] = ss; }
            if (fq == 0) {
#pragma unroll
                for (int ai = 0; ai < 2; ++ai)
#pragma unroll
                    for (int m = 0; m < 4; ++m) atomicAdd((int*)ssq + row0 + ai * HALF + m * 16, __float2int_rn(ssr[ai][m] * SSQ_FX)); } }
    }
};

template <class Epi, class Sched, bool ALIGN_EPI = false, bool SP2 = false>
__device__ __forceinline__ void gemm_phase(PG8_LAS unsigned char* lds, const Gemm g, const Sched& S, const Epi& E, int wave_id  ) {
    int tid_l; asm volatile("v_mbcnt_lo_u32_b32 %0, -1, 0\n\tv_mbcnt_hi_u32_b32 %0, -1, %0" : "=v"(tid_l)); tid_l += wave_id * 64;
    const int tid = tid_l, wid = wave_id, lane = tid & 63, wr = wid >> 2, wc = wid & 3, fr = lane & 15, fq = lane >> 4;
    const int K = g.K, nt = K / BK;
    unsigned voffA[2], voffB[2];
#pragma unroll
    for (int i = 0; i < 2; ++i) { int R, C; stage_rc(tid * 16 + i * 8192, R, C); const int Rb = Epi::PERM ? ((R & ~31) + perm32(R & 31)) : R;
        voffA[i] = (unsigned)(R * K + C) * 2u; voffB[i] = (unsigned)(Rb * K + C) * 2u; }
    const unsigned kstep = (unsigned)(BK * 2);
    const unsigned hstep = (unsigned)HALF * K * 2;
    const unsigned tstep = 2 * hstep;
    const unsigned ldsw = (unsigned)wid * 1024u;
    const int aoff = lds_byte(wr * 64 + fr, fq * 8), boff = lds_byte(wc * 32 + fr, fq * 8);
#define PG8_SA(b, h) (((b) * 2 + (h)) * HTB)
#define PG8_SB(b, h) ((4 + (b) * 2 + (h)) * HTB)
    const __amdgpu_buffer_rsrc_t rsrc_voffA = __builtin_amdgcn_make_buffer_rsrc((void*)g.A, 0, 0x7ffffff0, 0x00020000), rsrc_voffB = __builtin_amdgcn_make_buffer_rsrc((void*)g.Bt, 0, 0x7ffffff0, 0x00020000);
#ifndef PG8_A_AUX
#define PG8_A_AUX 0
#endif
#ifndef PG8_B_AUX
#define PG8_B_AUX 0
#endif
    constexpr int aux_voffA = PG8_A_AUX, aux_voffB = PG8_B_AUX;
#define PG8_STAGE(bufoff, goff, voff) do { _Pragma("unroll") for (int _i = 0; _i < 2; ++_i) \
        __builtin_amdgcn_raw_ptr_buffer_load_lds(rsrc_##voff, (PG8_LAS unsigned*)(lds + (bufoff) + ldsw + _i * 8192), 16, (voff)[_i], (goff), 0, aux_##voff); } while (0)
#define PG8_LDA(dst, b, h) do { _Pragma("unroll") for (int m = 0; m < 4; ++m) _Pragma("unroll") for (int k = 0; k < 2; ++k) dst[m][k] = *(const PG8_LAS bf16x8*)(lds + PG8_SA(b, h) + aoff + m * 2048 + k * 1024); } while (0)
#define PG8_LDB(dst, b, h) do { _Pragma("unroll") for (int n = 0; n < 2; ++n) _Pragma("unroll") for (int k = 0; k < 2; ++k) dst[n][k] = *(const PG8_LAS bf16x8*)(lds + PG8_SB(b, h) + boff + n * 2048 + k * 1024); } while (0)
#define PG8_MMA(ai, bj, At, Bt) do { __builtin_amdgcn_s_setprio(1); _Pragma("unroll") for (int m = 0; m < 4; ++m) _Pragma("unroll") for (int n = 0; n < 2; ++n) _Pragma("unroll") for (int k = 0; k < 2; ++k) \
        acc[ai][bj][m][n] = __builtin_amdgcn_mfma_f32_16x16x32_bf16(Bt[n][k], At[m][k], acc[ai][bj][m][n], 0, 0, 0); __builtin_amdgcn_s_setprio(0); } while (0)
#define PG8_WAIT_V(n) asm volatile("s_waitcnt vmcnt(" #n ")" ::: "memory")
#define PG8_WAIT_L(n) asm volatile("s_waitcnt lgkmcnt(" #n ")" ::: "memory")
#define PG8_BAR __builtin_amdgcn_s_barrier()
#define PG8_SCHED __builtin_amdgcn_sched_barrier(0)
    Unit cur, nxt; int ui = 0;
    if (!S.next(0, cur)) return;
    f32x4 acc[2][2][4][2];
#pragma unroll
    for (int a = 0; a < 2; ++a)
#pragma unroll
        for (int b = 0; b < 2; ++b)
#pragma unroll
            for (int m = 0; m < 4; ++m)
#pragma unroll
                for (int n = 0; n < 2; ++n) acc[a][b][m][n] = (f32x4){0.f, 0.f, 0.f, 0.f};
    bf16x8 At[4][2], B0[2][2], B1[2][2];
    unsigned cA = (unsigned)cur.pm * g.a_panel_bytes, cB = (unsigned)cur.pn * tstep;
    S.a_ready(cur);
    if constexpr (SP2) {
        PG8_STAGE(PG8_SB(0, 0), cB, voffB); PG8_STAGE(PG8_SB(0, 1), cB + hstep, voffB); PG8_STAGE(PG8_SA(0, 0), cA, voffA); PG8_STAGE(PG8_SA(0, 1), cA + hstep, voffA);
        if (wr == 1) PG8_BAR;
        PG8_WAIT_V(2); PG8_BAR;
        PG8_STAGE(PG8_SB(1, 0), cB + kstep, voffB); PG8_STAGE(PG8_SA(1, 0), cA + kstep, voffA); PG8_STAGE(PG8_SB(1, 1), cB + hstep + kstep, voffB);
        PG8_WAIT_V(6); PG8_BAR;
    } else {
        PG8_STAGE(PG8_SB(0, 0), cB, voffB); PG8_STAGE(PG8_SA(0, 0), cA, voffA); PG8_STAGE(PG8_SB(0, 1), cB + hstep, voffB); PG8_STAGE(PG8_SA(0, 1), cA + hstep, voffA);
        if (wr == 1) PG8_BAR;
        PG8_WAIT_V(4); PG8_BAR;
        PG8_STAGE(PG8_SB(1, 0), cB + kstep, voffB); PG8_STAGE(PG8_SA(1, 0), cA + kstep, voffA); PG8_STAGE(PG8_SB(1, 1), cB + hstep + kstep, voffB);
        PG8_WAIT_V(6); PG8_BAR;
    }
    for (;;) {
        const bool has_next = S.next(ui + 1, nxt);
        const unsigned nA = has_next ? (unsigned)nxt.pm * g.a_panel_bytes : cA, nB = has_next ? (unsigned)nxt.pn * tstep : cB;
        for (int t = 0; t < nt; t += 2) {
            const bool last = (t == nt - 2);
            const unsigned a1 = cA + (unsigned)(t + 1) * kstep;
            const unsigned a2 = last ? nA : cA + (unsigned)(t + 2) * kstep, b2 = last ? nB : cB + (unsigned)(t + 2) * kstep;
            const unsigned a3 = a2 + kstep, b3 = b2 + kstep;
            if (last && has_next) S.a_ready(nxt);
            if constexpr (SP2) {
            PG8_LDB(B0, 0, 0); PG8_LDB(B1, 0, 1); PG8_SCHED; PG8_LDA(At, 0, 0); PG8_STAGE(PG8_SA(1, 1), a1 + hstep, voffA);
            PG8_WAIT_V(8); PG8_WAIT_L(0); PG8_BAR; PG8_MMA(0, 0, At, B0); PG8_MMA(0, 1, At, B1); PG8_BAR; PG8_SCHED;
            PG8_LDA(At, 0, 1); PG8_STAGE(PG8_SB(0, 0), b2, voffB); PG8_STAGE(PG8_SB(0, 1), b2 + hstep, voffB); PG8_STAGE(PG8_SA(0, 0), a2, voffA);
            PG8_WAIT_V(8); PG8_WAIT_L(0); PG8_BAR; PG8_MMA(1, 0, At, B0); PG8_MMA(1, 1, At, B1); PG8_BAR; PG8_SCHED;
            PG8_LDB(B0, 1, 0); PG8_LDB(B1, 1, 1); PG8_SCHED; PG8_LDA(At, 1, 0); PG8_STAGE(PG8_SA(0, 1), a2 + hstep, voffA);
            PG8_WAIT_V(8); PG8_WAIT_L(0); PG8_BAR; PG8_MMA(0, 0, At, B0); PG8_MMA(0, 1, At, B1); PG8_BAR; PG8_SCHED;
            PG8_LDA(At, 1, 1); PG8_STAGE(PG8_SB(1, 0), b3, voffB); PG8_STAGE(PG8_SB(1, 1), b3 + hstep, voffB); PG8_STAGE(PG8_SA(1, 0), a3, voffA);
            PG8_WAIT_V(8); PG8_WAIT_L(0); PG8_BAR; PG8_MMA(1, 0, At, B0); PG8_MMA(1, 1, At, B1); PG8_BAR; PG8_SCHED;
            } else {
            PG8_LDB(B0, 0, 0); PG8_SCHED; PG8_LDA(At, 0, 0); PG8_STAGE(PG8_SA(1, 1), a1 + hstep, voffA);
            PG8_WAIT_L(8); PG8_BAR; PG8_WAIT_L(0); PG8_MMA(0, 0, At, B0); PG8_BAR; PG8_SCHED;
            PG8_LDB(B1, 0, 1); PG8_STAGE(PG8_SB(0, 0), b2, voffB);
            PG8_BAR; PG8_WAIT_L(0); PG8_MMA(0, 1, At, B1); PG8_BAR;
            PG8_LDA(At, 0, 1); PG8_STAGE(PG8_SA(0, 0), a2, voffA);
            PG8_BAR; PG8_WAIT_L(0); PG8_MMA(1, 0, At, B0); PG8_BAR; PG8_SCHED;
            PG8_STAGE(PG8_SB(0, 1), b2 + hstep, voffB);
            PG8_WAIT_V(6); PG8_BAR; PG8_MMA(1, 1, At, B1); PG8_BAR;
            PG8_LDB(B0, 1, 0); PG8_SCHED; PG8_LDA(At, 1, 0); PG8_STAGE(PG8_SA(0, 1), a2 + hstep, voffA);
            PG8_WAIT_L(8); PG8_BAR; PG8_WAIT_L(0); PG8_MMA(0, 0, At, B0); PG8_BAR; PG8_SCHED;
            PG8_LDB(B1, 1, 1); PG8_STAGE(PG8_SB(1, 0), b3, voffB);
            PG8_BAR; PG8_WAIT_L(0); PG8_MMA(0, 1, At, B1); PG8_BAR;
            PG8_LDA(At, 1, 1); PG8_STAGE(PG8_SA(1, 0), a3, voffA);
            PG8_BAR; PG8_WAIT_L(0); PG8_MMA(1, 0, At, B0); PG8_BAR; PG8_SCHED;
            PG8_STAGE(PG8_SB(1, 1), b3 + hstep, voffB);
            PG8_WAIT_V(6); PG8_BAR; PG8_MMA(1, 1, At, B1); PG8_BAR;
            }
        }
        if constexpr (ALIGN_EPI) { if (wr == 0) PG8_BAR; }
        if constexpr (!Epi::AFTER_DRAIN) { E(acc, cur, wr, wc, fr, fq); S.done(cur); }
        if (!has_next) break;
#pragma unroll
        for (int a = 0; a < 2; ++a)
#pragma unroll
            for (int b = 0; b < 2; ++b)
#pragma unroll
                for (int m = 0; m < 4; ++m)
#pragma unroll
                    for (int n = 0; n < 2; ++n) acc[a][b][m][n] = (f32x4){0.f, 0.f, 0.f, 0.f};
        cur = nxt; cA = nA; cB = nB; ++ui;
        if constexpr (ALIGN_EPI) { if (wr == 1) PG8_BAR; }
    }
    PG8_WAIT_V(0);
    if constexpr (!ALIGN_EPI) { if (wr == 0) PG8_BAR; }
    PG8_BAR;
    if constexpr (Epi::AFTER_DRAIN) { E.fused(acc, cur, wr, wc, fr, fq, lds, wid, lane); S.done(cur); }
#undef PG8_SA
#undef PG8_SB
#undef PG8_STAGE
#undef PG8_LDA
#undef PG8_LDB
#undef PG8_MMA
#undef PG8_WAIT_V
#undef PG8_WAIT_L
#undef PG8_BAR
#undef PG8_SCHED
}
}

#ifndef PG8_SP2
#define PG8_SP2 true
#endif
#ifndef PG8_ALIGN
#define PG8_ALIGN true
#endif
constexpr int NWAVES = 8;
constexpr int BATCH = 4, SEQ = 4096, D = 1024, M = BATCH * SEQ, NIN = 2816, FF = 4096, NLAYER = 2, ADA = 6 * D;
constexpr int C_AQ = 0, C_AK = 512, C_AV = 640, C_RQ = 768, C_RK = 1280, C_RV = 1792, C_RG = 2304;
constexpr float EPS = 1e-6f;

constexpr size_t MiB = 1u << 20;
constexpr size_t WS_CTL = 0, CTL_ZERO_BYTES = 1 * MiB;
constexpr size_t WS_SW = 64 * 1024;
constexpr size_t WS_SSQ = 768 * 1024;
constexpr size_t WS_ADA = 512 * 1024;
constexpr size_t WS_W = 1 * MiB, W_LAYER = 47 * MiB / 2;
constexpr size_t WO_IN = 0, WO_OUT = 11 * MiB / 2, WO_1 = 15 * MiB / 2, WO_2 = 31 * MiB / 2;
constexpr size_t WS_XN = 48 * MiB;
constexpr size_t WS_H = 80 * MiB;
constexpr size_t WS_PROJ = 80 * MiB;
constexpr size_t WS_MIX = WS_H + 256u * NIN * 2;
constexpr size_t WS_KV = 208 * MiB;
constexpr size_t WS_PREV = 240 * MiB;
constexpr size_t WS_END = 256 * MiB;
static_assert(WS_W + NLAYER * W_LAYER <= WS_XN && WS_XN + (size_t)M * D * 2 <= WS_H && WS_H + (size_t)M * FF * 2 <= WS_KV && WS_PREV + 512u * 16384 * 2 <= WS_END, "d_ws map");
constexpr int CW_TMO = 0, CW_CODE = 1;
constexpr int CW_BAR = 4096;
constexpr int CW_SWCNT = 320;
constexpr int CW_TEAM = 65536;
constexpr int CW_XCC = CW_TEAM + (NLAYER + 1) * 64 * 64;
constexpr int CW_XEV = 98304;
constexpr int CW_MIX = 8192;

constexpr int RING_OFF = 0, RING_BYTES = 131072;
constexpr int LDSCTL_OFF = RING_BYTES, MISC_OFF = LDSCTL_OFF + 320;
constexpr int RSTG_OFF = RING_BYTES + 1024;
constexpr int LDS_BYTES = 163840;
static_assert(MISC_OFF + 256 <= RSTG_OFF && RSTG_OFF + 8 * 2560 <= LDS_BYTES, "LDS map");

#define GAS __attribute__((address_space(1)))
#define LAS __attribute__((address_space(3)))
typedef unsigned short bf16;
typedef unsigned v4u __attribute__((ext_vector_type(4)));
typedef float f32x4 __attribute__((ext_vector_type(4)));
typedef short bf16x8 __attribute__((ext_vector_type(8)));
typedef GAS unsigned gu32;
typedef GAS unsigned long long gu64;
#define RLX_AGENT __ATOMIC_RELAXED, __HIP_MEMORY_SCOPE_AGENT
#define LDS_WAIT() asm volatile("s_waitcnt lgkmcnt(0)" ::: "memory")
#define VM_WAIT() asm volatile("s_waitcnt vmcnt(0)" ::: "memory")
__device__ __forceinline__ unsigned long long rt() { return __builtin_amdgcn_s_memrealtime(); }

__device__ __forceinline__ unsigned pk2(float lo, float hi) { typedef float f2_ __attribute__((ext_vector_type(2))); typedef __bf16 b2_ __attribute__((ext_vector_type(2))); f2_ v = {lo, hi}; b2_ b = __builtin_convertvector(v, b2_); return __builtin_bit_cast(unsigned, b); }
__device__ __forceinline__ unsigned f2bf(float f) { return pk2(f, f) & 0xffffu; }

#define XB_TMO      128
#define XB_XCNT(j)  (256  + 64 * (j))
#define XB_XSUB(j)  (1280 + 64 * (j))
#define XB_XGEN(j)  (2304 + 64 * (j))
#define XB_TOP      3328
#define XB_TOPGEN   3392
#define XCD_BAR_WORDS 3456
#define XB_SPIN_CAP (1u << 18)

__device__ __forceinline__ unsigned xb_ld(unsigned* p)              { return __hip_atomic_load(p, __ATOMIC_RELAXED, __HIP_MEMORY_SCOPE_AGENT); }
__device__ __forceinline__ unsigned xb_add(unsigned* p, unsigned v) { return __hip_atomic_fetch_add(p, v, __ATOMIC_RELAXED, __HIP_MEMORY_SCOPE_AGENT); }
__device__ __forceinline__ unsigned xb_xcc_id() { return (unsigned)__builtin_amdgcn_s_getreg((3 << 11) | 20) & 0xFu; }
#define XB_SPIN(cond, bar) do { unsigned _sp = 0; while (cond) { __builtin_amdgcn_s_sleep(1); \
    if ((++_sp & 255u) == 0u) { if (xb_ld(&(bar)[XB_TMO])) break; if (_sp > XB_SPIN_CAP) { atomicAdd(&(bar)[XB_TMO], 1u); break; } } } } while (0)

struct XcdBarrier {
    unsigned* bar; unsigned x;
    volatile LAS unsigned* st;
};

__device__ __forceinline__ XcdBarrier xcd_barrier_post(unsigned* bar, volatile LAS unsigned* st, int tid) {
    XcdBarrier b; b.bar = bar; b.x = xb_xcc_id(); b.st = st;
    if (tid == 0) (void)xb_add(&bar[XB_XCNT(b.x)], 1u);
    return b;
}
__device__ __forceinline__ void xcd_barrier_complete(unsigned* bar, unsigned x, unsigned& nloc, unsigned& nx) {
    const unsigned G = gridDim.x * gridDim.y * gridDim.z;
    unsigned sum, cnt, mine, sp = 0u;
    for (;;) {
        sum = 0u; cnt = 0u; mine = 0u;
#pragma unroll
        for (unsigned j = 0; j < 16; ++j) { const unsigned c = xb_ld(&bar[XB_XCNT(j)]); sum += c; cnt += (c > 0u) ? 1u : 0u; mine = (j == x) ? c : mine; }
        if (sum == G) break;
        __builtin_amdgcn_s_sleep(1);
        if ((++sp & 255u) == 0u) { if (xb_ld(&bar[XB_TMO])) break; if (sp > XB_SPIN_CAP) { atomicAdd(&bar[XB_TMO], 1u); break; } }
    }
    nloc = mine > 0u ? mine : 1u; nx = cnt > 0u ? cnt : 1u;
}

__device__ __forceinline__ void xcd_barrier(const XcdBarrier& b, int tid) {
    asm volatile("s_waitcnt vmcnt(0)" ::: "memory");
    __syncthreads();
    if (tid == 0) {
        unsigned* bar = b.bar;
        __builtin_amdgcn_s_waitcnt(0);
        unsigned nloc = b.st[0], nx = b.st[1];
        if (nloc == 0u) { xcd_barrier_complete(bar, b.x, nloc, nx); b.st[0] = nloc; b.st[1] = nx; }
        const unsigned old = xb_add(&bar[XB_XSUB(b.x)], 1u);
        const unsigned gen = old / nloc;
        if (old + 1u == (gen + 1u) * nloc) {
            __builtin_amdgcn_fence(__ATOMIC_RELEASE, "agent");
            asm volatile("s_waitcnt vmcnt(0)" ::: "memory");
            const unsigned og = xb_add(&bar[XB_TOP], 1u);
            const unsigned tg = og / nx;
            if (og + 1u == (tg + 1u) * nx) xb_add(&bar[XB_TOPGEN], 1u);
            else XB_SPIN(xb_ld(&bar[XB_TOPGEN]) == tg, bar);
            __builtin_amdgcn_fence(__ATOMIC_ACQUIRE, "agent");
            xb_add(&bar[XB_XGEN(b.x)], 1u);
            asm volatile("s_waitcnt vmcnt(0)" ::: "memory");
        } else {
            XB_SPIN(xb_ld(&bar[XB_XGEN(b.x)]) == gen, bar);
            __builtin_amdgcn_fence(__ATOMIC_ACQUIRE, "agent");
            asm volatile("s_waitcnt vmcnt(0)" ::: "memory");
        }
    }
    __syncthreads();
}

struct Args { const float* in[14]; float* out; unsigned char* ws; };
typedef const __attribute__((address_space(4))) Args* ArgsP;
__device__ __forceinline__ ArgsP get_args() { ArgsP p = (ArgsP)__builtin_amdgcn_kernarg_segment_ptr(); asm volatile("" : "+s"(p)); return p; }
struct Frame {
    LAS unsigned char* lds;
    ArgsP ap;
    int tid, lane, wave;
    int vcu, G;
    int wave0, vcu0, G0;
};
#define F_X(F) ((F).ap->in[0])
#define F_C(F) ((F).ap->in[1])
#define F_N1G(F) ((F).ap->in[2])
#define F_N2G(F) ((F).ap->in[3])
#define F_WADA(F) ((F).ap->in[4])
#define F_BADA(F) ((F).ap->in[5])
#define F_WIN(F) ((F).ap->in[6])
#define F_QNG(F) ((F).ap->in[7])
#define F_KNG(F) ((F).ap->in[8])
#define F_SINKS(F) ((F).ap->in[9])
#define F_RNG(F) ((F).ap->in[10])
#define F_WOUT(F) ((F).ap->in[11])
#define F_W1(F) ((F).ap->in[12])
#define F_W2(F) ((F).ap->in[13])
#define F_OUT(F) ((F).ap->out)
#define F_WS(F) ((F).ap->ws)
#define F_ADA(F) ((float*)((F).ap->ws + WS_ADA))
#define LAUNDER(F) do { (F).ap = get_args(); int l_; asm volatile("v_mbcnt_lo_u32_b32 %0, -1, 0\n\tv_mbcnt_hi_u32_b32 %0, -1, %0" : "=v"(l_)); int w_ = (F).wave0, c_ = (F).vcu0, g_ = (F).G0; asm volatile("" : "+s"(w_), "+s"(c_), "+s"(g_)); (F).lane = l_; (F).wave = w_; (F).vcu = c_; (F).G = g_; (F).tid = w_ * 64 + l_; } while (0)
__device__ __forceinline__ float bf2f(unsigned short u) { return __uint_as_float(((unsigned)u) << 16); }
__device__ __forceinline__ float bflo(unsigned u) { return __uint_as_float(u << 16); }
__device__ __forceinline__ float bfhi(unsigned u) { return __uint_as_float(u & 0xffff0000u); }
__device__ __forceinline__ void unpack8(const v4u w, float* f) { f[0] = bflo(w.x); f[1] = bfhi(w.x); f[2] = bflo(w.y); f[3] = bfhi(w.y); f[4] = bflo(w.z); f[5] = bfhi(w.z); f[6] = bflo(w.w); f[7] = bfhi(w.w); }
__device__ __forceinline__ float shx(float v, int mask, int lane) { return __int_as_float(__builtin_amdgcn_ds_bpermute((lane ^ mask) << 2, __float_as_int(v))); }
__device__ __forceinline__ float wave_sum(float v, int lane) {
#pragma unroll
    for (int o = 1; o < 64; o <<= 1) v += shx(v, o, lane);
    return v;
}
__device__ __forceinline__ float ret_log_gamma(int h) { return log1pf(-exp2f(-5.0f - (float)h)); }

__device__ __forceinline__ void p0_transpose_item(const float* W, int K, int N, bf16* WT, int row_off, LAS float* scr, int item, int lane) {
    const int nblk = N / 32, kb = item / nblk, nb = item % nblk, k0 = 64 * kb, n0 = 32 * nb;
    f32x4 wv[8];
#pragma unroll
    for (int i = 0; i < 8; ++i) wv[i] = __builtin_nontemporal_load((const GAS f32x4*)(W + (size_t)(k0 + 8 * i + (lane >> 3)) * N + n0 + 4 * (lane & 7)));
#pragma unroll
    for (int i = 0; i < 8; ++i) { LAS float* d = scr + (8 * i + (lane >> 3)) * 33 + 4 * (lane & 7); d[0] = wv[i].x; d[1] = wv[i].y; d[2] = wv[i].z; d[3] = wv[i].w; }
    LDS_WAIT(); asm volatile("" ::: "memory");
    const int c = lane & 7;
#pragma unroll
    for (int j = 0; j < 4; ++j) { const int n = (lane >> 3) + 8 * j; const LAS float* s = scr + (8 * c) * 33 + n;
        v4u o; o.x = pk2(s[0 * 33], s[1 * 33]); o.y = pk2(s[2 * 33], s[3 * 33]); o.z = pk2(s[4 * 33], s[5 * 33]); o.w = pk2(s[6 * 33], s[7 * 33]);
        *(GAS v4u*)(WT + (size_t)(row_off + n0 + n) * K + k0 + 8 * c) = o; }
    LDS_WAIT(); asm volatile("" ::: "memory");
}
constexpr int ADA_KS = 32, ADA_NKS = D / ADA_KS, ADA_NCB = ADA / 256;
__device__ __forceinline__ void p0_ada_item(Frame& F, int item, LAS float* scr) {
    const int ks = item % ADA_NKS, cb = (item / ADA_NKS) % ADA_NCB, l = item / (ADA_NKS * ADA_NCB), k0 = ks * ADA_KS, j = cb * 256 + 4 * F.lane;
    const GAS f32x4* w = (const GAS f32x4*)(F_WADA(F) + ((size_t)l * D + k0) * ADA + j);
    f32x4 wv[ADA_KS];
#pragma unroll
    for (int k = 0; k < ADA_KS; ++k) wv[k] = __builtin_nontemporal_load(w + (size_t)k * (ADA / 4));
    if (F.lane < ADA_KS) {
#pragma unroll
        for (int b = 0; b < BATCH; ++b) { const float cv = F_C(F)[b * D + k0 + F.lane]; scr[F.lane * 4 + b] = cv / (1.0f + __expf(-cv)); } }
    LDS_WAIT(); asm volatile("" ::: "memory");
    f32x4 a[BATCH];
#pragma unroll
    for (int b = 0; b < BATCH; ++b) a[b] = (f32x4){0.f, 0.f, 0.f, 0.f};
#pragma unroll
    for (int k = 0; k < ADA_KS; ++k) { const f32x4 cv = *(const LAS f32x4*)(scr + k * 4); a[0] += wv[k] * cv.x; a[1] += wv[k] * cv.y; a[2] += wv[k] * cv.z; a[3] += wv[k] * cv.w; }
    if (ks == 0) { const f32x4 bv = *(const GAS f32x4*)(F_BADA(F) + l * ADA + j);
#pragma unroll
        for (int b = 0; b < BATCH; ++b) a[b] += bv; }
    float* ad = F_ADA(F) + (size_t)(l * BATCH) * ADA + j;
#pragma unroll
    for (int b = 0; b < BATCH; ++b) { int* ai = (int*)(ad + b * ADA); atomicAdd(ai, __float2int_rn(a[b].x * pg8::ADA_FX)); atomicAdd(ai + 1, __float2int_rn(a[b].y * pg8::ADA_FX)); atomicAdd(ai + 2, __float2int_rn(a[b].z * pg8::ADA_FX)); atomicAdd(ai + 3, __float2int_rn(a[b].w * pg8::ADA_FX)); }
    LDS_WAIT(); asm volatile("" ::: "memory");
}
__device__ __forceinline__ void p0a_phase(Frame& F) {
    LAUNDER(F);
    LAS float* scr = (LAS float*)(F.lds + RING_OFF + F.wave * 16384);
    if (F.wave == 0) for (int it = F.vcu; it < 8 * ADA_NKS; it += F.G) p0_ada_item(F, it, scr);
}
__device__ __forceinline__ void p0_tr_dispatch(Frame& F, int r, LAS float* scr) {
    constexpr int I_IN = (D / 64) * (NIN / 32), I_O = (D / 64) * (D / 32), I_1 = (D / 64) * (FF / 32), I_2 = (FF / 64) * (D / 32), I_L = I_IN + I_O + I_1 + I_2;
    const int l = r / I_L; r -= l * I_L;
    bf16* wl = (bf16*)(F_WS(F) + WS_W + (size_t)l * W_LAYER);
    if (r < I_IN) { p0_transpose_item(F_WIN(F) + (size_t)l * D * NIN, D, NIN, wl + WO_IN / 2, 0, scr, r, F.lane); return; } r -= I_IN;
    if (r < I_O) { p0_transpose_item(F_WOUT(F) + (size_t)l * D * D, D, D, wl + WO_OUT / 2, 0, scr, r, F.lane); return; } r -= I_O;
    if (r < I_1) { p0_transpose_item(F_W1(F) + (size_t)l * D * FF, D, FF, wl + WO_1 / 2, 0, scr, r, F.lane); return; } r -= I_1;
    p0_transpose_item(F_W2(F) + (size_t)l * FF * D, FF, D, wl + WO_2 / 2, 0, scr, r, F.lane);
}
constexpr int TR_I_IN = (D / 64) * (NIN / 32), TR_I_O = (D / 64) * (D / 32), TR_I_L = TR_I_IN + TR_I_O + (D / 64) * (FF / 32) + (FF / 64) * (D / 32);
__device__ __forceinline__ void p0b_items(Frame& F) {
    LAUNDER(F);
    LAS float* scr = (LAS float*)(F.lds + RING_OFF + F.wave * 16384);
    const int gw = F.vcu * NWAVES + F.wave, NGW = F.G * NWAVES;
    constexpr int I_ADA = NLAYER * ADA_NCB * ADA_NKS - 8 * ADA_NKS;
    constexpr int NTR = NLAYER * TR_I_L;
    for (int it = gw; it < I_ADA + NTR; it += NGW) {
        if (it < I_ADA) { p0_ada_item(F, it + 8 * ADA_NKS, scr); continue; }
        p0_tr_dispatch(F, it - I_ADA, scr);
    }
}
__device__ __forceinline__ void sw_phase(Frame& F, int part, int nparts) {
    LAUNDER(F);
    const int gw = part * NWAVES + F.wave, NGW = nparts * NWAVES, lane = F.lane;
#pragma unroll 1
    for (int v = 0; v < 3; ++v) {
        const int l = (v == 0) ? 0 : 1, N = (v == 1) ? NIN : FF;
        const bf16* Wt = (const bf16*)(F_WS(F) + WS_W + (size_t)l * W_LAYER) + ((v == 1) ? WO_IN : WO_1) / 2;
        const float* sh = F_ADA(F) + (size_t)l * BATCH * ADA + ((v == 1) ? 0 : 3 * D);
        float* SW = (float*)(F_WS(F) + WS_SW) + (size_t)v * BATCH * 4096;
        f32x4 s[BATCH][4];
#pragma unroll
        for (int b = 0; b < BATCH; ++b)
#pragma unroll
            for (int j = 0; j < 4; ++j) s[b][j] = pg8::ld_ada4(sh + (size_t)b * ADA + (j >> 1) * 512 + lane * 8 + (j & 1) * 4);
        for (int n = gw; n < N; n += NGW) {
            const v4u w0 = *(const GAS v4u*)(Wt + (size_t)n * D + lane * 8), w1 = *(const GAS v4u*)(Wt + (size_t)n * D + 512 + lane * 8);
            float f[16]; unpack8(w0, f); unpack8(w1, f + 8);
            float acc[BATCH];
#pragma unroll
            for (int b = 0; b < BATCH; ++b) { acc[b] = 0.f;
#pragma unroll
                for (int j = 0; j < 4; ++j) acc[b] += (f[4 * j] * s[b][j].x + f[4 * j + 1] * s[b][j].y) + (f[4 * j + 2] * s[b][j].z + f[4 * j + 3] * s[b][j].w); }
#pragma unroll
            for (int b = 0; b < BATCH; ++b) acc[b] = wave_sum(acc[b], lane);
            if (lane < BATCH) SW[(size_t)lane * 4096 + n] = (lane == 0) ? acc[0] : (lane == 1) ? acc[1] : (lane == 2) ? acc[2] : acc[3];
        }
    }
}
__device__ __forceinline__ void xn_phase(Frame& F, const float* xsrc, const float* g, const float* shift, const float* scale, bf16* XN) {
    LAUNDER(F);
    const int gw = F.vcu * NWAVES + F.wave, NGW = F.G * NWAVES;
    for (int rb = gw; rb < M / 8; rb += NGW) {
        const int b = (rb * 8) / SEQ;
        f32x4 gm[4], sh[4];
#pragma unroll
        for (int j = 0; j < 4; ++j) { const int col = 256 * j + 4 * F.lane; const f32x4 gg = *(const f32x4*)(g + col), sc = pg8::ld_ada4(scale + (size_t)b * ADA + col); gm[j] = gg * (sc + 1.0f); sh[j] = pg8::ld_ada4(shift + (size_t)b * ADA + col); }
#pragma unroll 2
        for (int r = 0; r < 8; ++r) { const size_t row = (size_t)rb * 8 + r;
            const GAS f32x4* xr = (const GAS f32x4*)(xsrc + row * D) + F.lane;
            f32x4 v[4]; float s = 0.f;
#pragma unroll
            for (int j = 0; j < 4; ++j) { v[j] = __builtin_nontemporal_load(xr + 64 * j); s += (v[j].x * v[j].x + v[j].y * v[j].y) + (v[j].z * v[j].z + v[j].w * v[j].w); }
            const float rstd = 1.0f / sqrtf(wave_sum(s, F.lane) * (1.0f / D) + EPS);
            GAS unsigned long long* o8 = (GAS unsigned long long*)(XN + row * D) + F.lane;
#pragma unroll
            for (int j = 0; j < 4; ++j) { const f32x4 o = v[j] * rstd * gm[j] + sh[j]; o8[64 * j] = (unsigned long long)pk2(o.x, o.y) | ((unsigned long long)pk2(o.z, o.w) << 32); }
        }
    }
}

__device__ __forceinline__ void ret_scan(Frame& F, const float* KV, bf16* PREV) {
    LAUNDER(F);
    const int gt = F.vcu * (NWAVES * 64) + F.tid, NT = F.G * NWAVES * 64;
    for (int idx = gt; idx < BATCH * 4 * 8192; idx += NT) {
        const int de = idx & 8191, h = (idx >> 13) & 3, b = idx >> 15;
        const float cd = __expf(128.0f * ret_log_gamma(h));
        float s0 = 0.f, s1 = 0.f;
        const size_t base = ((size_t)(b * 32) * 4 + h) * 16384 + 2 * de;
        typedef float f32x2_t __attribute__((ext_vector_type(2)));
        f32x2_t kv[32];
#pragma unroll
        for (int n = 0; n < 32; ++n) kv[n] = __builtin_nontemporal_load((const GAS f32x2_t*)(KV + base + (size_t)n * 65536));
#pragma unroll
        for (int n = 0; n < 32; ++n) {
            const float p0 = cd * s0, p1 = cd * s1;
            *(GAS unsigned*)(PREV + base + (size_t)n * 65536) = pk2(p0, p1);
            s0 = p0 + kv[n].x; s1 = p1 + kv[n].y;
        }
    }
}

typedef float f32x16 __attribute__((ext_vector_type(16)));
typedef short s16x4 __attribute__((ext_vector_type(4)));
typedef short v4i16_t __attribute__((ext_vector_type(4)));
#define MFMA32(a, b, c) __builtin_amdgcn_mfma_f32_32x32x16_bf16((a), (b), (c), 0, 0, 0)
constexpr float LOG2E = 1.4426950408889634f;
__device__ __forceinline__ int crow(int r, int hi) { return (r & 3) + 8 * (r >> 2) + 4 * hi; }
__device__ __forceinline__ s16x4 vtr(const LAS unsigned char* p) { return __builtin_bit_cast(s16x4, __builtin_amdgcn_ds_read_tr16_b64_v4i16((LAS v4i16_t*)p)); }
__device__ __forceinline__ bf16x8 vfrag(const LAS unsigned char* p) { const s16x4 lo = vtr(p), hi = vtr(p + 512); return (bf16x8){lo[0], lo[1], lo[2], lo[3], hi[0], hi[1], hi[2], hi[3]}; }
__device__ __forceinline__ unsigned cvtpk(float lo, float hi) { typedef float f2 __attribute__((ext_vector_type(2))); typedef __bf16 b2 __attribute__((ext_vector_type(2))); f2 v = {lo, hi}; b2 b = __builtin_convertvector(v, b2); return __builtin_bit_cast(unsigned, b); }
__device__ __forceinline__ bf16x8 pack8(const f32x16& x, int s) {
    v4u p; p.x = cvtpk(x[8 * s], x[8 * s + 1]); p.y = cvtpk(x[8 * s + 2], x[8 * s + 3]); p.z = cvtpk(x[8 * s + 4], x[8 * s + 5]); p.w = cvtpk(x[8 * s + 6], x[8 * s + 7]);
    return __builtin_bit_cast(bf16x8, p);
}


__device__ __forceinline__ void mix_publish(int tid, unsigned* c0, unsigned* c1) {
    asm volatile("s_waitcnt vmcnt(0)" ::: "memory"); __syncthreads();
    if (tid == 0) { __builtin_amdgcn_fence(__ATOMIC_RELEASE, "agent"); asm volatile("s_waitcnt vmcnt(0)" ::: "memory");
        __hip_atomic_fetch_add(c0, 1u, __ATOMIC_RELAXED, __HIP_MEMORY_SCOPE_AGENT); if (c1) __hip_atomic_fetch_add(c1, 1u, __ATOMIC_RELAXED, __HIP_MEMORY_SCOPE_AGENT); }
}
__device__ __forceinline__ void mix_publish_xcc(int tid, unsigned* ev  , unsigned nloc, unsigned* c0, unsigned* c1) {
    asm volatile("s_waitcnt vmcnt(0)" ::: "memory"); __syncthreads();
    if (tid == 0) {
        const unsigned old = __hip_atomic_fetch_add(ev, 1u, __ATOMIC_RELAXED, __HIP_MEMORY_SCOPE_AGENT);
        if (old + 1u == nloc) { __builtin_amdgcn_fence(__ATOMIC_RELEASE, "agent"); asm volatile("s_waitcnt vmcnt(0)" ::: "memory");
            __hip_atomic_store(ev + 64, 1u, __ATOMIC_RELAXED, __HIP_MEMORY_SCOPE_AGENT); }
        else { unsigned sp = 0; while (__hip_atomic_load(ev + 64, __ATOMIC_RELAXED, __HIP_MEMORY_SCOPE_AGENT) == 0u) { __builtin_amdgcn_s_sleep(1); if (++sp > (1u << 22)) break; } }
        __hip_atomic_fetch_add(c0, 1u, __ATOMIC_RELAXED, __HIP_MEMORY_SCOPE_AGENT); if (c1) __hip_atomic_fetch_add(c1, 1u, __ATOMIC_RELAXED, __HIP_MEMORY_SCOPE_AGENT); }
}
__device__ __forceinline__ void mix_wait(int wave, unsigned* c0, unsigned w0, unsigned* c1, unsigned w1) {
    if (wave == 0) { unsigned sp = 0;
        asm volatile("buffer_inv sc1" ::: "memory");
        for (;;) { const unsigned a = (unsigned)__builtin_amdgcn_readfirstlane((int)__hip_atomic_load(c0, __ATOMIC_RELAXED, __HIP_MEMORY_SCOPE_AGENT));
            const unsigned b = c1 ? (unsigned)__builtin_amdgcn_readfirstlane((int)__hip_atomic_load(c1, __ATOMIC_RELAXED, __HIP_MEMORY_SCOPE_AGENT)) : w1;
            if (a >= w0 && b >= w1) break; __builtin_amdgcn_s_sleep(2); if (++sp > (1u << 22)) break; }
        asm volatile("s_waitcnt vmcnt(0)" ::: "memory"); }
    __syncthreads();
}
constexpr size_t PANEL_ELEMS = 1u << 20;
__device__ __forceinline__ const bf16* PRW(const bf16* PROJ, size_t row) { return PROJ + (row >> 8) * PANEL_ELEMS + (row & 255) * NIN; }
__device__ __forceinline__ bf16* MXW(bf16* MIX, size_t row) { return MIX + (row >> 8) * PANEL_ELEMS + (row & 255) * D; }
__device__ __forceinline__ void team_sync(int tid, int wave, unsigned* cnt, unsigned want, bool same_xcc, unsigned* guard = nullptr, unsigned gwant = 0u) {
    asm volatile("s_waitcnt vmcnt(0)" ::: "memory"); __syncthreads();
    if (wave == 0) {
        if (tid == 0) { if (!same_xcc) { __builtin_amdgcn_fence(__ATOMIC_RELEASE, "agent"); asm volatile("s_waitcnt vmcnt(0)" ::: "memory"); }
            __hip_atomic_fetch_add(cnt, 1u, __ATOMIC_RELAXED, __HIP_MEMORY_SCOPE_AGENT); }
        unsigned sp = 0;
        asm volatile("buffer_inv sc1" ::: "memory");
        for (;;) { const unsigned a = (unsigned)__builtin_amdgcn_readfirstlane((int)__hip_atomic_load(cnt, __ATOMIC_RELAXED, __HIP_MEMORY_SCOPE_AGENT));
            const unsigned g = guard ? (unsigned)__builtin_amdgcn_readfirstlane((int)__hip_atomic_load(guard, __ATOMIC_RELAXED, __HIP_MEMORY_SCOPE_AGENT)) : gwant;
            if (a >= want && g >= gwant) break; __builtin_amdgcn_s_sleep(1); if (++sp > (1u << 22)) break; }
        asm volatile("s_waitcnt vmcnt(0)" ::: "memory"); }
    __syncthreads();
}
__device__ __forceinline__ void attn_mfma(Frame& F, int layer, const bf16* PROJ, bf16* MIX) {
    LAUNDER(F);
    const int tid = F.tid, lane = F.lane, r32 = lane & 31, hi = lane >> 5, wid = F.wave;
    LAS unsigned char* Kl = F.lds + RING_OFF; LAS unsigned char* Vl = F.lds + RING_OFF + 32768;
    LAS float* wsf = (LAS float*)(F.lds + RING_OFF + 65536) + wid * 64;
    LAS unsigned short* stg = (LAS unsigned short*)(F.lds + RING_OFF + 65536 + 2048) + wid * 2048;
    const float* qg = F_QNG(F) + layer * 64; const float* kg = F_KNG(F) + layer * 64; const float* sk = F_SINKS(F) + layer * 8;
    const int vlane = (4 * hi + ((lane & 15) >> 2)) * 64 + ((lane >> 4) & 1) * 32 + (lane & 3) * 8;
    float qk_bound;
    { float a = fabsf(qg[lane]), b = fabsf(kg[lane]);
#pragma unroll
      for (int o = 1; o < 64; o <<= 1) { a = fmaxf(a, shx(a, o, lane)); b = fmaxf(b, shx(b, o, lane)); }
      qk_bound = 0.125f * LOG2E * 64.0f * 1.01f * a * b; }
    for (int u = F.vcu; u < BATCH * 32 * 2; u += F.G) {
        const int kvh = u & 1, n = (u >> 1) & 31, b = u >> 6;
        __syncthreads();
        { const int r = tid >> 1, hf = tid & 1; const int tok = (n - 1) * 128 + r;
          float kf[32]; float ss = 0.f; v4u vw[4];
          if (tok >= 0) {
              const bf16* kp = PRW(PROJ, (size_t)(b * SEQ + tok)) + C_AK + kvh * 64 + hf * 32;
              const bf16* vp = PRW(PROJ, (size_t)(b * SEQ + tok)) + C_AV + kvh * 64 + hf * 32;
#pragma unroll
              for (int i = 0; i < 4; ++i) { const v4u w = __builtin_nontemporal_load((const GAS v4u*)(kp + 8 * i)); unpack8(w, kf + 8 * i); vw[i] = __builtin_nontemporal_load((const GAS v4u*)(vp + 8 * i)); }
#pragma unroll
              for (int i = 0; i < 32; ++i) ss += kf[i] * kf[i];
          } else {
#pragma unroll
              for (int i = 0; i < 32; ++i) kf[i] = 0.f;
#pragma unroll
              for (int i = 0; i < 4; ++i) vw[i] = (v4u){0u, 0u, 0u, 0u};
          }
          ss += shx(ss, 1, lane);
          const float rstd = 1.0f / sqrtf(ss * (1.0f / 64.0f) + EPS);
#pragma unroll
          for (int i = 0; i < 4; ++i) { v4u o; const float* gp = kg + hf * 32 + 8 * i;
              o.x = pk2(kf[8 * i] * rstd * gp[0], kf[8 * i + 1] * rstd * gp[1]); o.y = pk2(kf[8 * i + 2] * rstd * gp[2], kf[8 * i + 3] * rstd * gp[3]);
              o.z = pk2(kf[8 * i + 4] * rstd * gp[4], kf[8 * i + 5] * rstd * gp[5]); o.w = pk2(kf[8 * i + 6] * rstd * gp[6], kf[8 * i + 7] * rstd * gp[7]);
              *(LAS v4u*)(Kl + (hf * 4 + i) * 4096 + r * 16) = o;
              *(LAS v4u*)(Vl + hf * 16384 + (r >> 4) * 1024 + (r & 15) * 64 + i * 16) = vw[i]; }
        }
        __syncthreads();
        const int h = kvh * 4 + (wid >> 1);
        const float slope2 = exp2f(-(float)(h + 1)) * LOG2E, sink2 = sk[h] * LOG2E;
        const float mref = fmaxf(qk_bound, sink2);
#pragma unroll 1
        for (int qt = 0; qt < 2; ++qt) {
            const int q0 = (wid & 1) * 64 + qt * 32, j0 = q0 >> 5;
            const size_t row = (size_t)b * SEQ + n * 128 + q0 + r32;
            bf16x8 qr[4];
            { float qf[32]; float ss = 0.f; const bf16* qp = PRW(PROJ, row) + C_AQ + h * 64 + 8 * hi;
#pragma unroll
              for (int d0 = 0; d0 < 4; ++d0) { const v4u w = __builtin_nontemporal_load((const GAS v4u*)(qp + 16 * d0)); unpack8(w, qf + 8 * d0); }
#pragma unroll
              for (int i = 0; i < 32; ++i) ss += qf[i] * qf[i];
              ss += shx(ss, 32, lane);
              const float sc = (1.0f / sqrtf(ss * (1.0f / 64.0f) + EPS)) * (0.125f * LOG2E);
#pragma unroll
              for (int d0 = 0; d0 < 4; ++d0) { const float* gp = qg + 16 * d0 + 8 * hi; v4u o;
                  o.x = pk2(qf[8 * d0] * sc * gp[0], qf[8 * d0 + 1] * sc * gp[1]); o.y = pk2(qf[8 * d0 + 2] * sc * gp[2], qf[8 * d0 + 3] * sc * gp[3]);
                  o.z = pk2(qf[8 * d0 + 4] * sc * gp[4], qf[8 * d0 + 5] * sc * gp[5]); o.w = pk2(qf[8 * d0 + 6] * sc * gp[6], qf[8 * d0 + 7] * sc * gp[7]);
                  qr[d0] = __builtin_bit_cast(bf16x8, o); } }
            int r32m = r32, him = hi; asm volatile("" : "+v"(r32m), "+v"(him));
            const float cinit = -slope2 * (float)(128 + r32m - 4 * him) - mref;
            f32x16 cv;
#pragma unroll
            for (int r = 0; r < 16; ++r) cv[r] = cinit;
            f32x16 p[5];
#pragma unroll
            for (int i = 0; i < 5; ++i) { f32x16 acc = cv;
#pragma unroll
                for (int d0 = 0; d0 < 4; ++d0) { const bf16x8 kfr = *(const LAS bf16x8*)(Kl + (2 * d0 + hi) * 4096 + (32 * (j0 + i) + r32) * 16); acc = MFMA32(kfr, qr[d0], acc); }
                p[i] = acc; }
            float l = 0.f;
#pragma unroll
            for (int i = 0; i < 5; ++i) { const bool tile_ok = (n > 0) || (j0 + i >= 4);
#pragma unroll
                for (int r = 0; r < 16; ++r) { const int cr = (r & 3) + 8 * (r >> 2);
                    float e = __builtin_amdgcn_exp2f(__builtin_fmaf(slope2, (float)(32 * i + cr), p[i][r]));
                    bool ok = tile_ok; if (i == 0) ok = ok && (cr + 4 * him > r32m); if (i == 4) ok = ok && (cr + 4 * him <= r32m);
                    e = ok ? e : 0.f; p[i][r] = e; l += e; } }
            l += shx(l, 32, lane); l += __builtin_amdgcn_exp2f(sink2 - mref);
            f32x16 o[2]; o[0] = (f32x16){}; o[1] = (f32x16){};
#pragma unroll
            for (int i = 0; i < 5; ++i)
#pragma unroll
                for (int s = 0; s < 2; ++s) { const bf16x8 pa = pack8(p[i], s);
#pragma unroll
                    for (int d0 = 0; d0 < 2; ++d0) { const bf16x8 vf = vfrag(Vl + d0 * 16384 + (2 * (j0 + i) + s) * 1024 + vlane); o[d0] = MFMA32(pa, vf, o[d0]); } }
            if (hi == 0) wsf[r32] = 1.0f / l;
            float rli[16];
#pragma unroll
            for (int r = 0; r < 16; ++r) rli[r] = wsf[crow(r, hi)];
#pragma unroll
            for (int r = 0; r < 16; ++r) { const int orow = crow(r, hi);
#pragma unroll
                for (int d0 = 0; d0 < 2; ++d0) stg[orow * 64 + d0 * 32 + r32] = (unsigned short)f2bf(o[d0][r] * rli[r]); }
            bf16* Ow = MXW(MIX, (size_t)b * SEQ + n * 128 + q0) + h * 64;
#pragma unroll
            for (int i = 0; i < 4; ++i) { const int orow = i * 8 + (lane >> 3), ch = lane & 7; const v4u v = *(const LAS v4u*)(stg + orow * 64 + ch * 8); *(GAS v4u*)(Ow + (size_t)orow * D + ch * 8) = v; }
        }
    }
    __syncthreads();
}

__device__ __forceinline__ void ret_kv_mfma(Frame& F, const bf16* PROJ, float* KVT, unsigned* cnt_kv  , unsigned* ev, unsigned nloc) {
    LAUNDER(F);
    const int tid = F.tid, lane = F.lane, r32 = lane & 31, hi = lane >> 5, wid = F.wave;
    const int vlane = (4 * hi + ((lane & 15) >> 2)) * 64 + ((lane >> 4) & 1) * 32 + (lane & 3) * 8;
    for (int up = F.vcu; up < 256; up += F.G) {
        __syncthreads();
#pragma unroll 1
        for (int U = 0; U < 2; ++U) { const int u = 2 * up + U, h = u & 3; const size_t row0 = (size_t)(u >> 2) * 128;
            const float lg = ret_log_gamma(h);
            const int r = tid >> 2, part = tid & 3;
            const bf16* kp = PRW(PROJ, row0 + r) + C_RK + h * 128 + part * 32;
            const bf16* vp = PRW(PROJ, row0 + r) + C_RV + h * 128 + part * 32;
            const float dk = __expf(lg * (float)(127 - r)) * 0.08838834764831845f;
            LAS unsigned char* kl = F.lds + RING_OFF + U * 65536 + part * 8192 + (r >> 4) * 1024 + (r & 15) * 64;
#pragma unroll
            for (int i = 0; i < 4; ++i) { const v4u w = *(const GAS v4u*)(kp + 8 * i); float f[8]; unpack8(w, f);
                v4u o; o.x = pk2(f[0] * dk, f[1] * dk); o.y = pk2(f[2] * dk, f[3] * dk); o.z = pk2(f[4] * dk, f[5] * dk); o.w = pk2(f[6] * dk, f[7] * dk);
                *(LAS v4u*)(kl + i * 16) = o;
                *(LAS v4u*)(kl + 32768 + i * 16) = *(const GAS v4u*)(vp + 8 * i); }
        }
        __syncthreads();
#pragma unroll 1
        for (int U = 0; U < 2; ++U) { const int u = 2 * up + U;
            const LAS unsigned char* kl = F.lds + RING_OFF + U * 65536; const LAS unsigned char* vl = kl + 32768;
            const int et = wid >> 1, dt0 = 2 * (wid & 1);
            f32x16 a0 = {}, a1 = {};
#pragma unroll
            for (int ks = 0; ks < 8; ++ks) { const bf16x8 av = vfrag(vl + et * 8192 + ks * 1024 + vlane);
                const bf16x8 b0 = vfrag(kl + dt0 * 8192 + ks * 1024 + vlane), b1 = vfrag(kl + (dt0 + 1) * 8192 + ks * 1024 + vlane);
                a0 = MFMA32(av, b0, a0); a1 = MFMA32(av, b1, a1); }
            float* op = KVT + (size_t)u * 16384 + (size_t)(32 * et) * 128 + 32 * dt0 + r32;
#pragma unroll
            for (int r = 0; r < 16; ++r) { const int e = crow(r, hi); op[e * 128] = a0[r]; op[e * 128 + 32] = a1[r]; }
        }
        { const int u0 = 2 * up, bh0 = ((u0 >> 7) << 2) | (u0 & 3);
          mix_publish_xcc(tid, ev, nloc, cnt_kv + 64 * bh0, cnt_kv + 64 * (bh0 + 1)); }
    }
    __syncthreads();
}
__device__ __forceinline__ void ret_out_mfma(Frame& F, int layer, const bf16* PROJ, const bf16* PREVT, bf16* MIX, unsigned* sc0, unsigned* sc1  ) {
    LAUNDER(F);
    const int tid = F.tid, lane = F.lane, r32 = lane & 31, hi = lane >> 5, wid = F.wave;
    const int vlane = (4 * hi + ((lane & 15) >> 2)) * 64 + ((lane >> 4) & 1) * 32 + (lane & 3) * 8;
    const float* gain = F_RNG(F) + layer * 512;
    for (int up = F.vcu; up < 256; up += F.G) {
        __syncthreads();
        const int U = wid >> 2, it = U ? 3 - (wid & 3) : (wid & 3);
        const int u = 2 * up + U, h = u & 3; const size_t row = (size_t)(u >> 2) * 128 + 32 * it + r32;
        bf16x8 qf[8];
        { const bf16* qp = PRW(PROJ, row) + C_RQ + h * 128 + 8 * hi;
#pragma unroll
          for (int ds = 0; ds < 8; ++ds) qf[ds] = __builtin_nontemporal_load((const GAS bf16x8*)(qp + 16 * ds)); }
#pragma unroll 1
        for (int Us = 0; Us < 2; ++Us) { const int us = 2 * up + Us, hs = us & 3; const size_t row0 = (size_t)(us >> 2) * 128;
            const float lg = ret_log_gamma(hs);
            const int r = tid >> 2, part = tid & 3;
            const bf16* kp = PRW(PROJ, row0 + r) + C_RK + hs * 128 + part * 32;
            const bf16* vp = PRW(PROJ, row0 + r) + C_RV + hs * 128 + part * 32;
            const float dk = __expf(lg * (float)(127 - r)) * 0.08838834764831845f;
            LAS unsigned char* kl = F.lds + RING_OFF + Us * 65536 + (part * 4) * 2048 + r * 16;
            LAS unsigned char* vl = F.lds + RING_OFF + Us * 65536 + 32768 + part * 8192 + (r >> 4) * 1024 + (r & 15) * 64;
#pragma unroll
            for (int i = 0; i < 4; ++i) { const v4u w = __builtin_nontemporal_load((const GAS v4u*)(kp + 8 * i)); float f[8]; unpack8(w, f);
                v4u o; o.x = pk2(f[0] * dk, f[1] * dk); o.y = pk2(f[2] * dk, f[3] * dk); o.z = pk2(f[4] * dk, f[5] * dk); o.w = pk2(f[6] * dk, f[7] * dk);
                *(LAS v4u*)(kl + i * 2048) = o;
                *(LAS v4u*)(vl + i * 16) = __builtin_nontemporal_load((const GAS v4u*)(vp + 8 * i)); }
        }
        __syncthreads();
        const LAS unsigned char* kl = F.lds + RING_OFF + U * 65536; const LAS unsigned char* vl = kl + 32768;
        f32x16 acc[4];
#pragma unroll
        for (int et = 0; et < 4; ++et) acc[et] = (f32x16){};
#pragma unroll 1
        for (int jt = 0; jt <= it; ++jt) {
            f32x16 S = {};
#pragma unroll
            for (int ds = 0; ds < 8; ++ds) { const bf16x8 kfr = *(const LAS bf16x8*)(kl + (2 * ds + hi) * 2048 + (32 * jt + r32) * 16); S = MFMA32(kfr, qf[ds], S); }
            if (jt == it) {
#pragma unroll
                for (int r = 0; r < 16; ++r) S[r] = (crow(r, hi) <= r32) ? S[r] : 0.f; }
            const bf16x8 pb0 = pack8(S, 0), pb1 = pack8(S, 1);
#pragma unroll
            for (int et = 0; et < 4; ++et) { const bf16x8 v0 = vfrag(vl + et * 8192 + (2 * jt) * 1024 + vlane), v1 = vfrag(vl + et * 8192 + (2 * jt + 1) * 1024 + vlane);
                acc[et] = MFMA32(v0, pb0, acc[et]); acc[et] = MFMA32(v1, pb1, acc[et]); }
        }
        mix_wait(wid, sc0, 16u, sc1, 16u);
        { const bf16* pp = PREVT + (size_t)u * 16384 + (size_t)r32 * 128 + 8 * hi;
#pragma unroll
          for (int ds = 0; ds < 8; ++ds)
#pragma unroll
              for (int et = 0; et < 4; ++et) { const bf16x8 pa = *(const GAS bf16x8*)(pp + (size_t)(32 * et) * 128 + 16 * ds); acc[et] = MFMA32(pa, qf[ds], acc[et]); } }
        const float dq = __expf(ret_log_gamma(h) * (float)(32 * it + r32 - 127));
        float s1 = 0.f;
#pragma unroll
        for (int et = 0; et < 4; ++et)
#pragma unroll
            for (int r = 0; r < 16; ++r) { acc[et][r] *= dq; s1 += acc[et][r]; }
        s1 += shx(s1, 32, lane);
        const float mu = s1 * (1.0f / 128.0f);
        float s2 = 0.f;
#pragma unroll
        for (int et = 0; et < 4; ++et)
#pragma unroll
            for (int r = 0; r < 16; ++r) { acc[et][r] -= mu; s2 += acc[et][r] * acc[et][r]; }
        s2 += shx(s2, 32, lane);
        const float rstd = 1.0f / sqrtf(s2 * (1.0f / 128.0f) + EPS);
        { LAS unsigned char* stg = F.lds + RSTG_OFF + wid * 2560;
          const size_t rowb = (size_t)(u >> 2) * 128 + 32 * it;
          const int orow = lane >> 2, oc = lane & 3;
          v4u gw[4][2];
#pragma unroll
          for (int et = 0; et < 4; ++et)
#pragma unroll
              for (int j = 0; j < 2; ++j) gw[et][j] = __builtin_nontemporal_load((const GAS v4u*)(PRW(PROJ, rowb + 16 * j + orow) + C_RG + h * 128 + 32 * et + 8 * oc));
#pragma unroll
          for (int et = 0; et < 4; ++et) {
#pragma unroll
              for (int rg = 0; rg < 4; ++rg) { typedef unsigned u32x2 __attribute__((ext_vector_type(2))); u32x2 w;
                  w.x = cvtpk(acc[et][4 * rg] * rstd, acc[et][4 * rg + 1] * rstd); w.y = cvtpk(acc[et][4 * rg + 2] * rstd, acc[et][4 * rg + 3] * rstd);
                  *(LAS u32x2*)(stg + r32 * 80 + (8 * rg + 4 * hi) * 2) = w; }
#pragma unroll
              for (int j = 0; j < 2; ++j) { const v4u yw = *(const LAS v4u*)(stg + (16 * j + orow) * 80 + oc * 16);
                  float y[8], g[8]; unpack8(yw, y); unpack8(gw[et][j], g);
                  const float* gn = gain + h * 128 + 32 * et + 8 * oc; const f32x4 g0 = *(const f32x4*)gn, g1 = *(const f32x4*)(gn + 4);
                  const float gv[8] = {g0.x, g0.y, g0.z, g0.w, g1.x, g1.y, g1.z, g1.w};
                  float o[8];
#pragma unroll
                  for (int e = 0; e < 8; ++e) o[e] = (g[e] * __builtin_amdgcn_rcpf(1.0f + __builtin_amdgcn_exp2f(-LOG2E * g[e]))) * y[e] * gv[e];
                  v4u ow; ow.x = pk2(o[0], o[1]); ow.y = pk2(o[2], o[3]); ow.z = pk2(o[4], o[5]); ow.w = pk2(o[6], o[7]);
                  *(GAS v4u*)(MXW(MIX, rowb + 16 * j + orow) + 512 + h * 128 + 32 * et + 8 * oc) = ow; }
          }
        }
    }
    __syncthreads();
}
#ifndef CHAOS
#define CHAOS 0
#endif
#define CHAOS_DELAY(which, cond) do { if (CHAOS == (which) && (cond)) { const unsigned long long t0_ = __builtin_amdgcn_s_memrealtime(); while (__builtin_amdgcn_s_memrealtime() - t0_ < 10000ull) __builtin_amdgcn_s_sleep(32); } } while (0)
__global__ void __launch_bounds__(NWAVES * 64, 2) fwd(Args args_unused_directly) {
    extern __shared__ __attribute__((aligned(16))) unsigned char lds[];
    Frame F;
    F.lds = (LAS unsigned char*)lds;
    F.wave0 = __builtin_amdgcn_readfirstlane((int)threadIdx.x >> 6);
    F.G0 = gridDim.x; { const int bx = blockIdx.x; F.vcu0 = (F.G0 % 8 == 0) ? (bx % 8) * (F.G0 / 8) + bx / 8 : bx; }
    LAUNDER(F);
    volatile LAS unsigned* MISC = (volatile LAS unsigned*)(F.lds + MISC_OFF);
    for (int u = F.tid; u < (LDS_BYTES - LDSCTL_OFF) / 4; u += NWAVES * 64) ((LAS unsigned*)(F.lds + LDSCTL_OFF))[u] = 0u;
    __syncthreads();
    XcdBarrier bar = xcd_barrier_post((unsigned*)(F_WS(F) + WS_CTL) + CW_BAR, MISC + 8, F.tid);
    if (F.tid == 0) __hip_atomic_store((unsigned*)(F_WS(F) + WS_CTL) + CW_XCC + F.vcu0, (unsigned)(__builtin_amdgcn_s_getreg((3 << 11) | 20) & 0xFu) + 1u, __ATOMIC_RELAXED, __HIP_MEMORY_SCOPE_AGENT);
#define GRID_BAR() do { LAUNDER(F); bar.bar = (unsigned*)(F_WS(F) + WS_CTL) + CW_BAR; { unsigned x_; asm volatile("s_getreg_b32 %0, hwreg(HW_REG_XCC_ID, 0, 4)" : "=s"(x_)); bar.x = x_ & 0xFu; } xcd_barrier(bar, F.tid); } while (0)
#define WSP(off) (get_args()->ws + (off))
#define TEAM_T (F.vcu >> 2)
#define TEAM_Q (F.vcu & 3)
#define TEAM_CNT(l_, t_) ((unsigned*)(F_WS(F) + WS_CTL) + CW_TEAM + ((l_) * 64 + (t_)) * 64)
#define TEAM_XCC(t_) ({ const unsigned* xt_ = (const unsigned*)(F_WS(F) + WS_CTL) + CW_XCC + 4 * (t_); const unsigned a_ = __hip_atomic_load(xt_, __ATOMIC_RELAXED, __HIP_MEMORY_SCOPE_AGENT), b_ = __hip_atomic_load(xt_ + 1, __ATOMIC_RELAXED, __HIP_MEMORY_SCOPE_AGENT), \
        c_ = __hip_atomic_load(xt_ + 2, __ATOMIC_RELAXED, __HIP_MEMORY_SCOPE_AGENT), d_ = __hip_atomic_load(xt_ + 3, __ATOMIC_RELAXED, __HIP_MEMORY_SCOPE_AGENT); (unsigned)__builtin_amdgcn_readfirstlane((int)((a_ == b_ && a_ == c_ && a_ == d_) ? a_ : 0u)); })
#define TEAM_SAME() (TEAM_XCC(TEAM_T) != 0u)
#define TEAM_SAME_NEXT() ({ const unsigned me_ = TEAM_XCC(TEAM_T); const unsigned nx_ = ((TEAM_T & 15) != 15) ? TEAM_XCC(TEAM_T + 1) : me_; (bool)(me_ != 0u && me_ == nx_); })
#define TEAM_SYNC(l_, stage_) do { LAUNDER(F); team_sync(F.tid, F.wave, TEAM_CNT(l_, TEAM_T), 4u * (unsigned)(stage_), TEAM_SAME()); } while (0)
#define TEAM_SYNC_X(l_, stage_) do { LAUNDER(F); team_sync(F.tid, F.wave, TEAM_CNT(l_, TEAM_T), 4u * (unsigned)(stage_), TEAM_SAME_NEXT()); } while (0)
#define TEAM_SYNC_GUARD(l_, stage_, gt_, gstage_) do { LAUNDER(F); team_sync(F.tid, F.wave, TEAM_CNT(l_, TEAM_T), 4u * (unsigned)(stage_), TEAM_SAME(), TEAM_CNT(l_, gt_), 4u * (unsigned)(gstage_)); } while (0)
#define INPROJ(l_) do { LAUNDER(F); const bf16* wl = (const bf16*)(F_WS(F) + WS_W + (size_t)(l_) * W_LAYER); \
        pg8::Gemm g{(const bf16*)(F_WS(F) + WS_XN), wl + WO_IN / 2, M, NIN, D, 256u * D * 2u}; pg8::TeamOrder S{TEAM_T, 3 * TEAM_Q, (TEAM_Q == 3) ? 2 : 3}; \
        if ((l_) == 0) { pg8::EpiBf16<0, 0> E{(bf16*)(F_WS(F) + WS_PROJ), NIN, nullptr, nullptr, 0, SEQ, 0.f, 0.f, (unsigned)PANEL_ELEMS}; \
            pg8::gemm_phase<pg8::EpiBf16<0, 0>, pg8::TeamOrder, PG8_ALIGN, PG8_SP2>(F.lds + RING_OFF, g, S, E, F.wave); \
            if (TEAM_Q == 3) { sw_phase(F, TEAM_T, 64); LAUNDER(F); mix_publish(F.tid, (unsigned*)(F_WS(F) + WS_CTL) + CW_SWCNT, nullptr); } } \
        else { pg8::EpiBf16<0, 1> E{(bf16*)(F_WS(F) + WS_PROJ), NIN, (const float*)(F_WS(F) + WS_SSQ) + 1 * M, (const float*)(F_WS(F) + WS_SW) + 1 * BATCH * 4096, 4096, SEQ, 1.0f / D, EPS, (unsigned)PANEL_ELEMS}; \
            pg8::gemm_phase<pg8::EpiBf16<0, 1>, pg8::TeamOrder, PG8_ALIGN, PG8_SP2>(F.lds + RING_OFF, g, S, E, F.wave); } } while (0)

    p0a_phase(F); p0b_items(F); GRID_BAR();
    CHAOS_DELAY(1, (F.vcu0 >> 2) & 1);
    { LAUNDER(F); const float* ada_0 = F_ADA(F);
      xn_phase(F, F_X(F), F_N1G(F), ada_0 + 0 * D, ada_0 + 1 * D, (bf16*)(F_WS(F) + WS_XN));
      TEAM_SYNC(NLAYER, 1); INPROJ(0); TEAM_SYNC_X(NLAYER, 2); }
#pragma unroll 1
    for (int l = 0; l < NLAYER; ++l) {
        {
            unsigned* cnt_kv = (unsigned*)(get_args()->ws + WS_CTL) + CW_MIX + (l * 2 + 0) * 1024;
#define XEV(l_, e_) ((unsigned*)(get_args()->ws + WS_CTL) + CW_XEV + ((((l_) * 2 + (e_)) * 16 + (int)((unsigned)__builtin_amdgcn_s_getreg((3 << 11) | 20) & 0xFu)) * 128))
            ret_kv_mfma(F, (const bf16*)WSP(WS_PROJ), (float*)WSP(WS_KV), cnt_kv, XEV(l, 0), MISC[8]);
            { LAUNDER(F);
              if (TEAM_Q < 2 && (TEAM_T & 15) != 0) mix_wait(F.wave, TEAM_CNT((l == 0) ? NLAYER : l - 1, TEAM_T - 1), (l == 0) ? 8u : 20u, nullptr, 0u); }
            CHAOS_DELAY(2, ((F.vcu0 >> 2) & 1) == 0); CHAOS_DELAY(5, (F.vcu0 & 3) == 2);
            attn_mfma(F, l, (const bf16*)WSP(WS_PROJ), (bf16*)WSP(WS_MIX));
            { LAUNDER(F); cnt_kv = (unsigned*)(F_WS(F) + WS_CTL) + CW_MIX + (l * 2 + 0) * 1024;
              const int bh = F.vcu >> 4; mix_wait(F.wave, cnt_kv + 64 * bh, 32u, nullptr, 0u);
              ret_scan(F, (const float*)WSP(WS_KV), (bf16*)WSP(WS_PREV));
              LAUNDER(F); mix_publish_xcc(F.tid, XEV(l, 1), MISC[8], (unsigned*)(F_WS(F) + WS_CTL) + CW_MIX + (l * 2 + 1) * 1024 + 64 * (F.vcu >> 4), nullptr); }
            { const int u0 = 2 * F.vcu0, bh0 = ((u0 >> 7) << 2) | (u0 & 3); unsigned* cs = (unsigned*)(get_args()->ws + WS_CTL) + CW_MIX + (l * 2 + 1) * 1024;
              ret_out_mfma(F, l, (const bf16*)WSP(WS_PROJ), (const bf16*)WSP(WS_PREV), (bf16*)WSP(WS_MIX), cs + 64 * bh0, cs + 64 * (bh0 + 1)); }
            TEAM_SYNC(l, 1);
        }
        {
            { LAUNDER(F); const bf16* wl = (const bf16*)(F_WS(F) + WS_W + (size_t)l * W_LAYER); const float* ada_l = F_ADA(F) + (size_t)l * BATCH * ADA;
              pg8::Gemm g{(const bf16*)(F_WS(F) + WS_MIX), wl + WO_OUT / 2, M, D, D, (unsigned)(PANEL_ELEMS * 2)}; pg8::TeamOrder S{TEAM_T, TEAM_Q, 1};
              if (l == 0) { pg8::EpiResGate<1, 0, 1> E{F_X(F), F_OUT(F), D, ada_l + 2 * D, ADA, SEQ, (bf16*)(F_WS(F) + WS_XN), F_N2G(F) + l * D, ada_l + 4 * D, (float*)(F_WS(F) + WS_SSQ) + (size_t)(2 * l) * M, 256u * D, 524288u};
                  pg8::gemm_phase<pg8::EpiResGate<1, 0, 1>, pg8::TeamOrder, PG8_ALIGN, PG8_SP2>(F.lds + RING_OFF, g, S, E, F.wave); }
              else { pg8::EpiResGate<1, 1, 1> E{F_OUT(F), F_WS(F) + WS_KV, D, ada_l + 2 * D, ADA, SEQ, (bf16*)(F_WS(F) + WS_XN), F_N2G(F) + l * D, ada_l + 4 * D, (float*)(F_WS(F) + WS_SSQ) + (size_t)(2 * l) * M, 524288u, 256u * D};
                  pg8::gemm_phase<pg8::EpiResGate<1, 1, 1>, pg8::TeamOrder, PG8_ALIGN, PG8_SP2>(F.lds + RING_OFF, g, S, E, F.wave); } }
            CHAOS_DELAY(3, (F.vcu0 >> 2) & 1);
            if ((TEAM_T & 15) != 15) TEAM_SYNC_GUARD(l, 2, TEAM_T + 1, 1); else TEAM_SYNC(l, 2);
            CHAOS_DELAY(4, ((F.vcu0 >> 2) % 3) == 0);
            if (l == 0) { LAUNDER(F); mix_wait(F.wave, (unsigned*)(F_WS(F) + WS_CTL) + CW_SWCNT, 64u, nullptr, 0u); }
            { LAUNDER(F); const bf16* wl = (const bf16*)(F_WS(F) + WS_W + (size_t)l * W_LAYER);
              pg8::Gemm g{(const bf16*)(F_WS(F) + WS_XN), wl + WO_1 / 2, M, FF, D, 256u * D * 2u}; pg8::TeamOrder S{TEAM_T, 4 * TEAM_Q, 4};
              pg8::EpiBf16<1, 1> E{(bf16*)(F_WS(F) + WS_H), FF, (const float*)(F_WS(F) + WS_SSQ) + (size_t)(2 * l) * M, (const float*)(F_WS(F) + WS_SW) + (size_t)(2 * l) * BATCH * 4096, 4096, SEQ, 1.0f / D, EPS, 256u * FF};
              pg8::gemm_phase<pg8::EpiBf16<1, 1>, pg8::TeamOrder, PG8_ALIGN, PG8_SP2>(F.lds + RING_OFF, g, S, E, F.wave); }
            TEAM_SYNC(l, 3);
            { LAUNDER(F); const bf16* wl = (const bf16*)(F_WS(F) + WS_W + (size_t)l * W_LAYER); const float* ada_l = F_ADA(F) + (size_t)l * BATCH * ADA;
              pg8::Gemm g{(const bf16*)(F_WS(F) + WS_H), wl + WO_2 / 2, M, D, FF, 256u * FF * 2u}; pg8::TeamOrder S{TEAM_T, TEAM_Q, 1};
              if (l + 1 < NLAYER) { const float* ada_n = ada_l + (size_t)BATCH * ADA;
                  pg8::EpiResGate<1, 1, 1> E{F_OUT(F), F_OUT(F), D, ada_l + 5 * D, ADA, SEQ, (bf16*)(F_WS(F) + WS_XN), F_N1G(F) + (l + 1) * D, ada_n + 1 * D, (float*)(F_WS(F) + WS_SSQ) + (size_t)(2 * l + 1) * M, 524288u, 524288u};
                  pg8::gemm_phase<pg8::EpiResGate<1, 1, 1>, pg8::TeamOrder, PG8_ALIGN, PG8_SP2>(F.lds + RING_OFF, g, S, E, F.wave); }
              else { pg8::EpiResGate<0, 1, 0> E{F_WS(F) + WS_KV, F_OUT(F), D, ada_l + 5 * D, ADA, SEQ, nullptr, nullptr, nullptr, nullptr, 256u * D, 256u * D};
                  pg8::gemm_phase<pg8::EpiResGate<0, 1, 0>, pg8::TeamOrder, PG8_ALIGN, PG8_SP2>(F.lds + RING_OFF, g, S, E, F.wave); } }
            CHAOS_DELAY(6, ((F.vcu0 >> 2) & 3) == 1);
            if (l + 1 < NLAYER) { TEAM_SYNC(l, 4); INPROJ(l + 1); TEAM_SYNC_X(l, 5); }
        }
    }
}

extern "C" void kernel_launch(void* const* d_in, const int* in_sizes, int n_in, void* d_out, int out_size, void* d_ws, size_t ws_size, hipStream_t stream) {
    static int grid = 0;
    if (grid == 0) {
        if (n_in != 14 || in_sizes[0] != M * D || out_size != M * D || ws_size < WS_END) { fprintf(stderr, "kernel_launch: unexpected shapes (n_in %d, in0 %d, out %d, ws %zu); nothing launched\n", n_in, n_in > 0 ? in_sizes[0] : -1, out_size, ws_size); grid = -1; return; }
        int dev = 0, cus = 0, per_cu = 0;
        if (hipGetDevice(&dev) != hipSuccess || hipDeviceGetAttribute(&cus, hipDeviceAttributeMultiprocessorCount, dev) != hipSuccess) { grid = -1; return; }
        if (hipFuncSetAttribute((const void*)fwd, hipFuncAttributeMaxDynamicSharedMemorySize, LDS_BYTES) != hipSuccess) { fprintf(stderr, "kernel_launch: hipFuncSetAttribute failed\n"); grid = -1; return; }
        if (hipOccupancyMaxActiveBlocksPerMultiprocessor(&per_cu, (const void*)fwd, NWAVES * 64, LDS_BYTES) != hipSuccess || per_cu < 1) { fprintf(stderr, "kernel_launch: occupancy query reports %d blocks per CU\n", per_cu); }
        (void)hipGetLastError();
        grid = cus;
        if (cus != 256) { fprintf(stderr, "kernel_launch: built for a 256-CU device (work maps are static per workgroup); this device reports %d CUs; nothing launched\n", cus); grid = -1; return; }
    }
    if (grid < 0) return;
    if (hipMemsetAsync((char*)d_ws + WS_CTL, 0, CTL_ZERO_BYTES, stream) != hipSuccess) { fprintf(stderr, "kernel_launch: hipMemsetAsync failed\n"); return; }
    Args a{};
    for (int i = 0; i < 14; ++i) a.in[i] = (const float*)d_in[i];
    a.out = (float*)d_out; a.ws = (unsigned char*)d_ws;
    hipLaunchKernelGGL(fwd, dim3(grid), dim3(NWAVES * 64), LDS_BYTES, stream, a);
    const hipError_t le = hipPeekAtLastError();
    if (le != hipSuccess) fprintf(stderr, "kernel_launch: launch failed: %s\n", hipGetErrorName(le));
}
```
